# Optimizing an MI355X kernel written in HIP

```python
import math
import jax, jax.numpy as jnp
from jax import lax
import numpy as np

D_MODEL = 2048
BATCH = 4
SEQ = 4096
DEPTH = 1

EPS = 1e-6
NEG_INF = -1e30
TINY = 1e-30
FORCE_SCORE = 1e4

NSA_HEADS = 16
NSA_KV_GROUPS = 4
NSA_REP = NSA_HEADS // NSA_KV_GROUPS
NSA_HEAD_DIM = 128
N_NSA_BRANCH = 3
CMP_BLOCK = 32
CMP_STRIDE = 16
SLC_BLOCK = 64
SLC_TOPK = 16
WINDOW = 512
NSA_QBLOCK = 32

GDN_HEADS = 16
GDN_HEAD_DIM = 128
GDN_CONV = 4
GDN_CHUNK = 64

D_FF = -(-(8 * D_MODEL) // (3 * 256)) * 256

NSA_Q_DIM = NSA_HEADS * NSA_HEAD_DIM
NSA_KV_DIM = N_NSA_BRANCH * 2 * NSA_KV_GROUPS * NSA_HEAD_DIM
NSA_GATE_DIM = NSA_HEADS * N_NSA_BRANCH
GDN_QKV_DIM = 3 * GDN_HEADS * GDN_HEAD_DIM
GDN_Z_DIM = GDN_HEADS * GDN_HEAD_DIM
IN_SPLITS = (NSA_Q_DIM, NSA_KV_DIM, NSA_GATE_DIM, GDN_QKV_DIM, GDN_Z_DIM, GDN_HEADS, GDN_HEADS, D_MODEL, D_MODEL)
D_IN = sum(IN_SPLITS)

kernel_name = "hybrid_nsa_gdn_swiglu_block"


def _rms_norm(t, gain):
    tf = t.astype(jnp.float32)
    y = tf * lax.rsqrt(jnp.mean(tf * tf, axis=-1, keepdims=True) + EPS)
    return (y * gain.astype(jnp.float32)).astype(t.dtype)


def _l2norm(t):
    tf = t.astype(jnp.float32)
    return tf * lax.rsqrt(jnp.sum(tf * tf, axis=-1, keepdims=True) + EPS)


def _masked_softmax(s, mask):
    s = jnp.where(mask, s.astype(jnp.float32), NEG_INF)
    e = jnp.where(mask, jnp.exp(s - jnp.max(s, axis=-1, keepdims=True)), 0.0)
    return e / jnp.maximum(jnp.sum(e, axis=-1, keepdims=True), TINY)


def _split_cols(t, sizes):
    out, start = [], 0
    for s in sizes:
        out.append(t[..., start:start + s])
        start += s
    return out


def _nsa_mixer(q, kv, gate_logits, q_gain, k_gain, cmp_pos, w_cmp):
    B_, S_, _ = q.shape
    G, R, dh = NSA_KV_GROUPS, NSA_REP, NSA_HEAD_DIM
    scale = dh ** -0.5
    q = _rms_norm(q.reshape(B_, S_, G, R, dh), q_gain)
    kv = kv.reshape(B_, S_, N_NSA_BRANCH, 2, G, dh)

    n_cmp = (S_ - CMP_BLOCK) // CMP_STRIDE + 1
    cmp_start = np.arange(n_cmp) * CMP_STRIDE
    blk_idx = cmp_start[:, None] + np.arange(CMP_BLOCK)[None, :]
    k_raw, v_raw = kv[:, :, 0, 0], kv[:, :, 0, 1]
    k_cmp = jnp.einsum('bnlgd,lde->bnge', k_raw[:, blk_idx] + cmp_pos[0][:, None, :], w_cmp[0])
    v_cmp = jnp.einsum('bnlgd,lde->bnge', v_raw[:, blk_idx] + cmp_pos[1][:, None, :], w_cmp[1])
    k_cmp = _rms_norm(k_cmp, k_gain[0])
    cmp_end = jnp.asarray(cmp_start + CMP_BLOCK - 1, jnp.int32)

    n_sel = S_ // SLC_BLOCK
    n_topk = min(SLC_TOPK, n_sel)
    k_sel = _rms_norm(kv[:, :, 1, 0], k_gain[1])
    k_sel_blocks = k_sel.reshape(B_, n_sel, SLC_BLOCK, G, dh).transpose(0, 3, 1, 2, 4)
    v_sel_blocks = kv[:, :, 1, 1].reshape(B_, n_sel, SLC_BLOCK, G, dh).transpose(0, 3, 1, 2, 4)
    sel_start = np.arange(n_sel) * SLC_BLOCK
    overlap = np.minimum(cmp_start[:, None] + CMP_BLOCK, sel_start[None, :] + SLC_BLOCK) - np.maximum(cmp_start[:, None], sel_start[None, :])
    agg = jnp.asarray(np.clip(overlap, 0, None) / CMP_BLOCK, jnp.float32)
    b_ix = jnp.arange(B_)[:, None, None, None]
    g_ix = jnp.arange(G)[None, None, :, None]

    k_win = jnp.pad(_rms_norm(kv[:, :, 2, 0], k_gain[2]), ((0, 0), (WINDOW, 0), (0, 0), (0, 0)))
    v_win = jnp.pad(kv[:, :, 2, 1], ((0, 0), (WINDOW, 0), (0, 0), (0, 0)))

    gates = jax.nn.sigmoid(gate_logits.astype(jnp.float32)).reshape(B_, S_, G, R, N_NSA_BRANCH)
    QC = NSA_QBLOCK
    nq = S_ // QC

    def block(args):
        qc, gc, start = args
        t = start + jnp.arange(QC, dtype=jnp.int32)
        s = jnp.einsum('bqgrd,bngd->bqgrn', qc, k_cmp) * scale
        p_cmp = _masked_softmax(s, (cmp_end[None, :] <= t[:, None])[None, :, None, None, :])
        o_cmp = jnp.einsum('bqgrn,bngd->bqgrd', p_cmp, v_cmp)
        imp = jnp.einsum('bqgrn,nj->bqgj', p_cmp, agg)
        blk = jnp.arange(n_sel, dtype=jnp.int32)[None, :]
        cur = t[:, None] // SLC_BLOCK
        forced = (blk == 0) | (blk == cur) | (blk == cur - 1)
        causal = blk * SLC_BLOCK <= t[:, None]
        score = jnp.where(forced[None, :, None, :], FORCE_SCORE, jnp.where(causal[None, :, None, :], imp, -FORCE_SCORE))
        _, sel = lax.top_k(score, n_topk)
        ks = k_sel_blocks[b_ix, g_ix, sel]
        vs = v_sel_blocks[b_ix, g_ix, sel]
        key_pos = sel[..., None] * SLC_BLOCK + jnp.arange(SLC_BLOCK, dtype=jnp.int32)
        m_sel = (key_pos <= t[None, :, None, None, None])[:, :, :, None].reshape(B_, QC, G, 1, n_topk * SLC_BLOCK)
        s = jnp.einsum('bqgrd,bqgkld->bqgrkl', qc, ks).reshape(B_, QC, G, R, n_topk * SLC_BLOCK) * scale
        p = _masked_softmax(s, m_sel).reshape(B_, QC, G, R, n_topk, SLC_BLOCK)
        o_slc = jnp.einsum('bqgrkl,bqgkld->bqgrd', p, vs)
        kw = lax.dynamic_slice_in_dim(k_win, start, WINDOW + QC, axis=1)
        vw = lax.dynamic_slice_in_dim(v_win, start, WINDOW + QC, axis=1)
        pos = start - WINDOW + jnp.arange(WINDOW + QC, dtype=jnp.int32)
        rel = t[:, None] - pos[None, :]
        m_win = ((pos[None, :] >= 0) & (rel >= 0) & (rel < WINDOW))[None, :, None, None, :]
        s = jnp.einsum('bqgrd,bkgd->bqgrk', qc, kw) * scale
        o_win = jnp.einsum('bqgrk,bkgd->bqgrd', _masked_softmax(s, m_win), vw)
        o = gc[..., 0:1] * o_cmp + gc[..., 1:2] * o_slc + gc[..., 2:3] * o_win
        return o.astype(qc.dtype)

    q_chunks = jnp.moveaxis(q.reshape(B_, nq, QC, G, R, dh), 1, 0)
    g_chunks = jnp.moveaxis(gates.reshape(B_, nq, QC, G, R, N_NSA_BRANCH), 1, 0)
    starts = jnp.arange(nq, dtype=jnp.int32) * QC
    out = lax.map(block, (q_chunks, g_chunks, starts))
    return jnp.moveaxis(out, 0, 1).reshape(B_, S_, G * R * dh)


def _gated_delta_chunked(q, k, v, g, beta):
    B_, S_, H, dk = q.shape
    dv = v.shape[-1]
    C = GDN_CHUNK
    N = S_ // C
    out_dtype = v.dtype

    def chunks(t):
        return jnp.moveaxis(t.astype(jnp.float32).reshape(B_, N, C, H, -1), 3, 2)

    q, k, v = chunks(q), chunks(k), chunks(v)
    g = jnp.cumsum(chunks(g[..., None])[..., 0], axis=-1)
    beta = chunks(beta[..., None])[..., 0]
    k_beta = k * beta[..., None]
    v_beta = v * beta[..., None]
    tril = np.tril(np.ones((C, C), bool))
    strict = np.tril(np.ones((C, C), bool), -1)
    diff = g[..., :, None] - g[..., None, :]
    decay = jnp.where(tril, jnp.exp(jnp.where(tril, diff, 0.0)), 0.0)
    a_mat = jnp.eye(C, dtype=jnp.float32) + jnp.where(strict, jnp.einsum('bnhid,bnhjd->bnhij', k_beta, k) * decay, 0.0)
    rhs = jnp.concatenate([v_beta, k_beta * jnp.exp(g)[..., None]], axis=-1)
    sol = lax.linalg.triangular_solve(a_mat, rhs, left_side=True, lower=True, unit_diagonal=True)
    u, w = sol[..., :dv], sol[..., dv:]
    qk = jnp.einsum('bnhid,bnhjd->bnhij', q, k) * decay

    def step(state, xs):
        q_c, k_c, u_c, w_c, g_c, qk_c = xs
        v_new = u_c - jnp.einsum('bhcd,bhde->bhce', w_c, state)
        o = jnp.einsum('bhcd,bhde->bhce', q_c * jnp.exp(g_c)[..., None], state) + jnp.einsum('bhij,bhje->bhie', qk_c, v_new)
        g_last = g_c[..., -1:]
        state = state * jnp.exp(g_last)[..., None] + jnp.einsum('bhcd,bhce->bhde', k_c * jnp.exp(g_last - g_c)[..., None], v_new)
        return state, o

    xs = tuple(jnp.moveaxis(t, 1, 0) for t in (q, k, u, w, g, qk))
    state0 = jnp.zeros((B_, H, dk, dv), jnp.float32)
    _, o = lax.scan(step, state0, xs)
    o = jnp.transpose(o, (1, 0, 3, 2, 4)).reshape(B_, S_, H, dv)
    return o.astype(out_dtype)


def _gdn_mixer(qkv, z, a, b, conv_w, a_log, dt_bias, out_gain):
    B_, S_, _ = qkv.shape
    H, d = GDN_HEADS, GDN_HEAD_DIM
    pad = jnp.pad(qkv, ((0, 0), (GDN_CONV - 1, 0), (0, 0)))
    conv = conv_w[0] * pad[:, 0:S_]
    for i in range(1, GDN_CONV):
        conv = conv + conv_w[i] * pad[:, i:i + S_]
    conv = jax.nn.silu(conv)
    q, k, v = jnp.split(conv, 3, axis=-1)
    q = _l2norm(q.reshape(B_, S_, H, d)) * (d ** -0.5)
    k = _l2norm(k.reshape(B_, S_, H, d))
    v = v.reshape(B_, S_, H, d)
    beta = jax.nn.sigmoid(b.astype(jnp.float32))
    g = -jnp.exp(a_log.astype(jnp.float32)) * jax.nn.softplus(a.astype(jnp.float32) + dt_bias.astype(jnp.float32))
    o = _gated_delta_chunked(q, k, v, g, beta)
    o = _rms_norm(o, out_gain) * jax.nn.silu(z.reshape(B_, S_, H, d))
    return o.reshape(B_, S_, H * d)


def setup_inputs(seed: int = 0) -> dict:
    key = jax.random.key(seed)
    ks = jax.random.split(key, 20)
    L, dh = DEPTH, NSA_HEAD_DIM

    def nrm(k, shape, scale):
        return jax.random.normal(k, shape, jnp.float32) * scale

    def gain(k, shape):
        return 1.0 + 0.02 * jax.random.normal(k, shape, jnp.float32)

    dt = jnp.exp(jax.random.uniform(ks[9], (L, GDN_HEADS), jnp.float32, minval=math.log(1e-3), maxval=math.log(1e-1)))
    return {
        "x": nrm(ks[0], (BATCH, SEQ, D_MODEL), 1.0),
        "attn_norm": gain(ks[1], (L, D_MODEL)),
        "w_in": nrm(ks[2], (L, D_MODEL, D_IN), D_MODEL ** -0.5),
        "nsa_q_norm": gain(ks[3], (L, dh)),
        "nsa_k_norm": gain(ks[4], (L, N_NSA_BRANCH, dh)),
        "cmp_pos": nrm(ks[5], (L, 2, CMP_BLOCK, dh), 0.1),
        "w_cmp": nrm(ks[6], (L, 2, CMP_BLOCK, dh, dh), (CMP_BLOCK * dh) ** -0.5),
        "gdn_conv": nrm(ks[7], (L, GDN_CONV, GDN_QKV_DIM), GDN_CONV ** -0.5),
        "gdn_a_log": jnp.log(jax.random.uniform(ks[8], (L, GDN_HEADS), jnp.float32, minval=1.0, maxval=16.0)),
        "gdn_dt_bias": dt + jnp.log(-jnp.expm1(-dt)),
        "gdn_out_norm": gain(ks[10], (L, GDN_HEAD_DIM)),
        "w_branch_a": nrm(ks[11], (L, NSA_Q_DIM, D_MODEL), NSA_Q_DIM ** -0.5),
        "w_branch_b": nrm(ks[12], (L, GDN_Z_DIM, D_MODEL), GDN_Z_DIM ** -0.5),
        "w_out": nrm(ks[13], (L, D_MODEL, D_MODEL), D_MODEL ** -0.5),
        "ffn_norm": gain(ks[14], (L, D_MODEL)),
        "w_gate": nrm(ks[15], (L, D_MODEL, D_FF), D_MODEL ** -0.5),
        "w_up": nrm(ks[16], (L, D_MODEL, D_FF), D_MODEL ** -0.5),
        "w_down": nrm(ks[17], (L, D_FF, D_MODEL), D_FF ** -0.5),
    }


def reference(x, attn_norm, w_in, nsa_q_norm, nsa_k_norm, cmp_pos, w_cmp, gdn_conv, gdn_a_log, gdn_dt_bias,
              gdn_out_norm, w_branch_a, w_branch_b, w_out, ffn_norm, w_gate, w_up, w_down):
    for l in range(DEPTH):
        h = _rms_norm(x, attn_norm[l])
        proj = h @ w_in[l]
        q_a, kv_a, gate_a, qkv_b, z_b, a_b, b_b, m_a, m_b = _split_cols(proj, IN_SPLITS)
        o_a = _nsa_mixer(q_a, kv_a, gate_a, nsa_q_norm[l], nsa_k_norm[l], cmp_pos[l], w_cmp[l])
        o_b = _gdn_mixer(qkv_b, z_b, a_b, b_b, gdn_conv[l], gdn_a_log[l], gdn_dt_bias[l], gdn_out_norm[l])
        mix = jax.nn.sigmoid(m_a) * (o_a @ w_branch_a[l]) + jax.nn.sigmoid(m_b) * (o_b @ w_branch_b[l])
        x = x + mix @ w_out[l]
        h2 = _rms_norm(x, ffn_norm[l])
        x = x + (jax.nn.silu(h2 @ w_gate[l]) * (h2 @ w_up[l])) @ w_down[l]
    return x
```

```cpp
#include <hip/hip_runtime.h>
#include <hip/hip_cooperative_groups.h>
#include <cstdio>
namespace cg = cooperative_groups;
namespace pg8 {
#define PG8_LAS __attribute__((address_space(3)))
typedef unsigned short bf16_t;
typedef short bf16x8 __attribute__((ext_vector_type(8)));
typedef float f32x4 __attribute__((ext_vector_type(4)));
typedef unsigned u32x4 __attribute__((ext_vector_type(4)));
constexpr int BM = 256, BK = 64, HALF = 128, HTB = HALF * BK * 2  , STAGE_BYTES = 8 * HTB, NXCD = 8, WGM = 8;

__host__ __device__ __forceinline__ int lds_byte(int r, int c) { const int st = (r >> 4) * 2 + (c >> 5), rr = r & 15, cc = c & 31, ob = rr * 64 + cc * 2; return st * 1024 + (ob ^ (((ob >> 9) & 1) << 5)); }
__host__ __device__ __forceinline__ void stage_rc(int b, int& R, int& C) { const int st = b / 1024, sb = b % 1024, swz = sb ^ (((sb >> 9) & 1) << 5); R = (st >> 1) * 16 + swz / 64; C = (st & 1) * 32 + (swz % 64) / 2; }
__host__ __device__ __forceinline__ int perm32(int rho) { const int n = rho >> 4, i = rho & 15; return 8 * (i >> 2) + 4 * n + (i & 3); }

struct Unit { int pm, pn; };
struct Gemm { const bf16_t* A; const bf16_t* Bt; int M, N, K; };

struct StaticOrder {
    int nM, nN, nwg, G, c;
    __host__ __device__ void init(int M, int N, int G_, int c_) { nM = M / BM; nN = N / BM; nwg = nM * nN; G = G_; c = c_; }
    __host__ __device__ bool next(int i, Unit& u) const {
        const long L = (long)i * G + c; if (L >= nwg) return false;
        int wgid = (int)L; { const int q = nwg / NXCD, r = nwg % NXCD, xcd = wgid % NXCD, off = wgid / NXCD; wgid = (xcd < r ? xcd * (q + 1) : r * (q + 1) + (xcd - r) * q) + off; }
        const int nig = WGM * nN, gid = wgid / nig, fm = gid * WGM, gsz = (nM - fm) < WGM ? (nM - fm) : WGM;
        u.pm = fm + ((wgid % nig) % gsz); u.pn = (wgid % nig) / gsz; return true;
    }
    __device__ __forceinline__ void a_ready(const Unit&) const {}
    __device__ __forceinline__ void done(const Unit&) const {}
};
__device__ __forceinline__ unsigned cvt_pk_bf16(float lo, float hi) { unsigned r; asm volatile("v_cvt_pk_bf16_f32 %0, %1, %2" : "=v"(r) : "v"(lo), "v"(hi)); return r; }

template <class Epi, class Sched, bool STAMP = false>
__device__ __forceinline__ void gemm_phase(PG8_LAS unsigned char* lds, const Gemm g, const Sched& S, const Epi& E, unsigned long long* stamps) {
    const int tid = threadIdx.x, wid = __builtin_amdgcn_readfirstlane(tid >> 6), lane = tid & 63, wr = wid >> 2, wc = wid & 3, fr = lane & 15, fq = lane >> 4;
    const int K = g.K, nt = K / BK;
    int ts_lo = 0, ts_hi = 0, nts = 0; const unsigned long long rt_entry = STAMP ? (unsigned long long)wall_clock64() : 0ull;
#define PG8_STAMP() do { if (STAMP && wid == 0 && nts < 64) { const unsigned long long _c = (unsigned long long)clock64(); \
        ts_lo = (lane == nts) ? (int)(unsigned)_c : ts_lo; ts_hi = (lane == nts) ? (int)(unsigned)(_c >> 32) : ts_hi; ++nts; } } while (0)
    PG8_STAMP();
    unsigned voffA[2], voffB[2];
#pragma unroll
    for (int i = 0; i < 2; ++i) { int R, C; stage_rc(tid * 16 + i * 8192, R, C); const int Rb = Epi::PERM ? ((R & ~31) + perm32(R & 31)) : R;
        voffA[i] = (unsigned)(R * K + C) * 2u; voffB[i] = (unsigned)(Rb * K + C) * 2u; }
    const size_t kstep = (size_t)(BK * 2);
    const size_t hstep = (size_t)HALF * K * 2;
    const size_t tstep = 2 * hstep;
    const unsigned ldsw = (unsigned)wid * 1024u;
    const int aoff = lds_byte(wr * 64 + fr, fq * 8), boff = lds_byte(wc * 32 + fr, fq * 8);
#define PG8_SA(b, h) (((b) * 2 + (h)) * HTB)
#define PG8_SB(b, h) ((4 + (b) * 2 + (h)) * HTB)
#define PG8_STAGE(bufoff, gbase, voff) do { _Pragma("unroll") for (int _i = 0; _i < 2; ++_i) \
        __builtin_amdgcn_global_load_lds((const unsigned*)((const char*)(gbase) + (voff)[_i]), (PG8_LAS unsigned*)(lds + (bufoff) + ldsw + _i * 8192), 16, 0, 0); } while (0)
#define PG8_LDA(dst, b, h) do { _Pragma("unroll") for (int m = 0; m < 4; ++m) _Pragma("unroll") for (int k = 0; k < 2; ++k) dst[m][k] = *(const PG8_LAS bf16x8*)(lds + PG8_SA(b, h) + aoff + m * 2048 + k * 1024); } while (0)
#define PG8_LDB(dst, b, h) do { _Pragma("unroll") for (int n = 0; n < 2; ++n) _Pragma("unroll") for (int k = 0; k < 2; ++k) dst[n][k] = *(const PG8_LAS bf16x8*)(lds + PG8_SB(b, h) + boff + n * 2048 + k * 1024); } while (0)
#define PG8_MMA(ai, bj, At, Bt) do { __builtin_amdgcn_s_setprio(1); _Pragma("unroll") for (int m = 0; m < 4; ++m) _Pragma("unroll") for (int n = 0; n < 2; ++n) _Pragma("unroll") for (int k = 0; k < 2; ++k) \
        acc[ai][bj][m][n] = __builtin_amdgcn_mfma_f32_16x16x32_bf16(Bt[n][k], At[m][k], acc[ai][bj][m][n], 0, 0, 0); __builtin_amdgcn_s_setprio(0); } while (0)
#define PG8_WAIT_V(n) asm volatile("s_waitcnt vmcnt(" #n ")" ::: "memory")
#define PG8_WAIT_L(n) asm volatile("s_waitcnt lgkmcnt(" #n ")" ::: "memory")
#define PG8_BAR __builtin_amdgcn_s_barrier()
#define PG8_SCHED __builtin_amdgcn_sched_barrier(0)
    Unit cur, nxt; int ui = 0;
    if (!S.next(0, cur)) return;
    f32x4 acc[2][2][4][2];
#pragma unroll
    for (int a = 0; a < 2; ++a)
#pragma unroll
        for (int b = 0; b < 2; ++b)
#pragma unroll
            for (int m = 0; m < 4; ++m)
#pragma unroll
                for (int n = 0; n < 2; ++n) acc[a][b][m][n] = (f32x4){0.f, 0.f, 0.f, 0.f};
    bf16x8 At[4][2], B0[2][2], B1[2][2];
    const char* cA = (const char*)g.A + (size_t)cur.pm * tstep; const char* cB = (const char*)g.Bt + (size_t)cur.pn * tstep;
    S.a_ready(cur);
    PG8_STAGE(PG8_SB(0, 0), cB, voffB); PG8_STAGE(PG8_SA(0, 0), cA, voffA); PG8_STAGE(PG8_SB(0, 1), cB + hstep, voffB); PG8_STAGE(PG8_SA(0, 1), cA + hstep, voffA);
    if (wr == 1) PG8_BAR;
    PG8_WAIT_V(4); PG8_BAR;
    PG8_STAGE(PG8_SB(1, 0), cB + kstep, voffB); PG8_STAGE(PG8_SA(1, 0), cA + kstep, voffA); PG8_STAGE(PG8_SB(1, 1), cB + hstep + kstep, voffB);
    PG8_WAIT_V(6); PG8_BAR;
    PG8_STAMP();
    for (;;) {
        const bool has_next = S.next(ui + 1, nxt);
        const char* nA = has_next ? (const char*)g.A + (size_t)nxt.pm * tstep : cA; const char* nB = has_next ? (const char*)g.Bt + (size_t)nxt.pn * tstep : cB;
        for (int t = 0; t < nt; t += 2) {
            const bool last = (t == nt - 2);
            const char* a1 = cA + (size_t)(t + 1) * kstep;
            const char* a2 = last ? nA : cA + (size_t)(t + 2) * kstep; const char* b2 = last ? nB : cB + (size_t)(t + 2) * kstep;
            const char* a3 = a2 + kstep; const char* b3 = b2 + kstep;
            if (last && has_next) S.a_ready(nxt);
            PG8_LDB(B0, 0, 0); PG8_SCHED; PG8_LDA(At, 0, 0); PG8_STAGE(PG8_SA(1, 1), a1 + hstep, voffA);
            PG8_WAIT_L(8); PG8_BAR; PG8_WAIT_L(0); PG8_MMA(0, 0, At, B0); PG8_BAR; PG8_SCHED;
            PG8_LDB(B1, 0, 1); PG8_STAGE(PG8_SB(0, 0), b2, voffB);
            PG8_BAR; PG8_WAIT_L(0); PG8_MMA(0, 1, At, B1); PG8_BAR;
            PG8_LDA(At, 0, 1); PG8_STAGE(PG8_SA(0, 0), a2, voffA);
            PG8_BAR; PG8_WAIT_L(0); PG8_MMA(1, 0, At, B0); PG8_BAR; PG8_SCHED;
            PG8_STAGE(PG8_SB(0, 1), b2 + hstep, voffB);
            PG8_WAIT_V(6); PG8_BAR; PG8_MMA(1, 1, At, B1); PG8_BAR;
            PG8_LDB(B0, 1, 0); PG8_SCHED; PG8_LDA(At, 1, 0); PG8_STAGE(PG8_SA(0, 1), a2 + hstep, voffA);
            PG8_WAIT_L(8); PG8_BAR; PG8_WAIT_L(0); PG8_MMA(0, 0, At, B0); PG8_BAR; PG8_SCHED;
            PG8_LDB(B1, 1, 1); PG8_STAGE(PG8_SB(1, 0), b3, voffB);
            PG8_BAR; PG8_WAIT_L(0); PG8_MMA(0, 1, At, B1); PG8_BAR;
            PG8_LDA(At, 1, 1); PG8_STAGE(PG8_SA(1, 0), a3, voffA);
            PG8_BAR; PG8_WAIT_L(0); PG8_MMA(1, 0, At, B0); PG8_BAR; PG8_SCHED;
            PG8_STAGE(PG8_SB(1, 1), b3 + hstep, voffB);
            PG8_WAIT_V(6); PG8_BAR; PG8_MMA(1, 1, At, B1); PG8_BAR;
        }
        PG8_STAMP();
        if constexpr (!Epi::AFTER_DRAIN) { E(acc, cur, wr, wc, fr, fq); S.done(cur); }
        PG8_STAMP();
        if (!has_next) break;
#pragma unroll
        for (int a = 0; a < 2; ++a)
#pragma unroll
            for (int b = 0; b < 2; ++b)
#pragma unroll
                for (int m = 0; m < 4; ++m)
#pragma unroll
                    for (int n = 0; n < 2; ++n) acc[a][b][m][n] = (f32x4){0.f, 0.f, 0.f, 0.f};
        cur = nxt; cA = nA; cB = nB; ++ui;
    }
    PG8_WAIT_V(0);
    if (wr == 0) PG8_BAR;
    PG8_BAR;
    if constexpr (Epi::AFTER_DRAIN) { E.fused(acc, cur, wr, wc, fr, fq, lds, wid, lane); S.done(cur); }
    PG8_STAMP();
    if (STAMP && wid == 0) { stamps[lane] = lane < nts ? (((unsigned long long)(unsigned)ts_hi << 32) | (unsigned)ts_lo) : 0ull;
        if (lane == 62) stamps[62] = rt_entry; if (lane == 63) stamps[63] = (unsigned long long)wall_clock64(); }
#undef PG8_STAMP
#undef PG8_SA
#undef PG8_SB
#undef PG8_STAGE
#undef PG8_LDA
#undef PG8_LDB
#undef PG8_MMA
#undef PG8_WAIT_V
#undef PG8_WAIT_L
#undef PG8_BAR
#undef PG8_SCHED
}
}

#define DI __device__ __forceinline__
#define LAS __attribute__((address_space(3)))
typedef unsigned short bf16_t;
typedef short bf16x8 __attribute__((ext_vector_type(8)));
typedef float f32x4 __attribute__((ext_vector_type(4)));
typedef float f32x16 __attribute__((ext_vector_type(16)));
typedef unsigned u32x4 __attribute__((ext_vector_type(4)));
typedef unsigned u32x2 __attribute__((ext_vector_type(2)));
typedef __bf16 bf2_t __attribute__((ext_vector_type(2)));
typedef float f2_t __attribute__((ext_vector_type(2)));
typedef unsigned long long u64;

constexpr int TH = 8192, SEQ = 4096, DM = 2048, NP = 17664, DFF = 5632;
constexpr int C_KV = 2048, C_GQ = 5120, C_Z = 11264, C_MA = 13312, C_MB = 15360, C_GATE = 17408, C_A = 17456, C_B = 17472;
constexpr float EPS = 1e-6f;
constexpr float QSCALE = 0.08838834764831845f * 1.4426950408889634f;

constexpr size_t WS_WAT = 0, WS_WBT = 8388608, WS_WOT = 16777216, WS_WCT = 25165824, WS_CMPC = 27262976, WS_CTR = 27264000,
                 WS_KC = 27267072, WS_VCT = 27791360, WS_SEL = 28315648, WS_GEXP = 28577792, WS_X = 28585984,
                 WS_H = WS_X, WS_WINT = WS_X + 33554432, WS_GQG = WS_X, WS_GKGT = WS_X + 33554432, WS_GW = WS_X + 67108864,
                 WS_PROJ = 134492160, WS_GU = 423899136, WS_GQK = 457453568, WS_VT = 474230784,
                 WS_X1 = WS_X, WS_H2 = 162803712, WS_WGT = 229912576, WS_WDT = 276049920, WS_ACT = 299118592;
constexpr size_t DO_OA = 0, DO_OB = 33554432, DO_MIX = 67108864;

struct Params { const float* in[18]; float* out; unsigned char* ws; };

DI unsigned pk2(float a, float b) { f2_t v = {a, b}; return __builtin_bit_cast(unsigned, __builtin_convertvector(v, bf2_t)); }
DI float bflo(unsigned u) { return __uint_as_float(u << 16); }
DI float bfhi(unsigned u) { return __uint_as_float(u & 0xffff0000u); }
DI float bf2f(bf16_t h) { return __uint_as_float((unsigned)h << 16); }
DI bf16_t f2bf(float x) { return (bf16_t)(pk2(x, 0.f) & 0xffffu); }
DI float wsum(float v) { for (int o = 32; o; o >>= 1) v += __shfl_xor(v, o); return v; }
DI float sigm(float x) { return 1.0f / (1.0f + __expf(-x)); }
DI float silu(float x) { return x / (1.0f + __expf(-x)); }
DI f32x16 mfma32(bf16x8 a, bf16x8 b, f32x16 c) { return __builtin_amdgcn_mfma_f32_32x32x16_bf16(a, b, c, 0, 0, 0); }
DI f32x16 zero16() { f32x16 z; for (int i = 0; i < 16; ++i) z[i] = 0.f; return z; }
DI int crow(int reg, int h) { return (reg & 3) + 8 * (reg >> 2) + 4 * h; }
DI bf16x8 pack8(const f32x16& x, int s) { u32x4 p; p[0] = pk2(x[8 * s], x[8 * s + 1]); p[1] = pk2(x[8 * s + 2], x[8 * s + 3]); p[2] = pk2(x[8 * s + 4], x[8 * s + 5]); p[3] = pk2(x[8 * s + 6], x[8 * s + 7]); return __builtin_bit_cast(bf16x8, p); }
DI bf16x8 cat8(u32x2 a, u32x2 b) { u32x4 p = {a[0], a[1], b[0], b[1]}; return __builtin_bit_cast(bf16x8, p); }

template <int MAP> DI int map_row(int n) {
    if (MAP == 0) return n;
    if (MAP == 1) { if (n < 5120) return n; if (n < 5168) return 17408 + (n - 5120); if (n < 13360) return n - 48; if (n < 13376) return 17456 + (n - 13360); if (n < 13392) return 17472 + (n - 13376); return n - 80; }
    if (MAP == 2) return (n >> 7) * 256 + (n & 127);
    return (n >> 7) * 256 + 128 + (n & 127);
}
template <int MAP> DI void xpose_tile(LAS float* tile, const float* src, int K, int N, bf16_t* dst, int kt, int nt, int tid) {
    const int k0 = kt * 64, n0 = nt * 64, r = tid >> 4, c4 = (tid & 15) * 4;
#pragma unroll
    for (int i = 0; i < 2; ++i) {
        const int n = n0 + c4; f32x4 v = {0.f, 0.f, 0.f, 0.f};
        if (n < N) v = *(const f32x4*)(src + (size_t)(k0 + r + 32 * i) * N + n);
        LAS float* d = tile + (r + 32 * i) * 65 + c4; d[0] = v[0]; d[1] = v[1]; d[2] = v[2]; d[3] = v[3];
    }
    __syncthreads();
    const int nl = tid >> 3, kc = tid & 7, n = n0 + nl;
    if (n < N) {
        u32x4 w;
#pragma unroll
        for (int j = 0; j < 4; ++j) w[j] = pk2(tile[(kc * 8 + 2 * j) * 65 + nl], tile[(kc * 8 + 2 * j + 1) * 65 + nl]);
        *(u32x4*)(dst + (size_t)map_row<MAP>(n) * K + k0 + kc * 8) = w;
    }
    __syncthreads();
}
template <int MAP> DI void xpose_all(LAS float* tile, const float* src, int K, int N, bf16_t* dst, int tid, int bid, int G) {
    const int nkt = K / 64, nnt = (N + 63) / 64, tot = nkt * nnt;
    for (int i = bid; i < tot; i += G) xpose_tile<MAP>(tile, src, K, N, dst, i / nnt, i % nnt, tid);
}
DI void norm_rows(const float* x, const float* gain, bf16_t* out, int nrows, int tid, int bid, int G) {
    const int w = tid >> 6, lane = tid & 63;
    for (int row = bid * 8 + w; row < nrows; row += G * 8) {
        f32x4 v[8]; float ss = 0.f;
#pragma unroll
        for (int i = 0; i < 8; ++i) { v[i] = *(const f32x4*)(x + (size_t)row * DM + i * 256 + lane * 4); ss += v[i][0] * v[i][0] + v[i][1] * v[i][1] + v[i][2] * v[i][2] + v[i][3] * v[i][3]; }
        ss = wsum(ss); const float rs = rsqrtf(ss * (1.0f / DM) + EPS);
#pragma unroll
        for (int i = 0; i < 8; ++i) { const f32x4 gn = *(const f32x4*)(gain + i * 256 + lane * 4);
            u32x2 o; o[0] = pk2(v[i][0] * rs * gn[0], v[i][1] * rs * gn[1]); o[1] = pk2(v[i][2] * rs * gn[2], v[i][3] * rs * gn[3]);
            *(u32x2*)(out + (size_t)row * DM + i * 256 + lane * 4) = o; }
    }
}

struct EpiProj { static constexpr bool PERM = true, AFTER_DRAIN = false; bf16_t* O;
    DI void operator()(const pg8::f32x4 (&acc)[2][2][4][2], const pg8::Unit& u, int wr, int wc, int fr, int fq) const {
        const int row0 = u.pm * 256 + wr * 64 + fr, col0 = u.pn * 256 + wc * 32 + 8 * fq;
#pragma unroll
        for (int ai = 0; ai < 2; ++ai)
#pragma unroll
            for (int m = 0; m < 4; ++m) { bf16_t* rowp = O + (size_t)(row0 + ai * 128 + m * 16) * NP + col0;
#pragma unroll
                for (int bj = 0; bj < 2; ++bj) { const pg8::f32x4 v0 = acc[ai][bj][m][0], v1 = acc[ai][bj][m][1];
                    u32x4 w; w[0] = pk2(v0[0], v0[1]); w[1] = pk2(v0[2], v0[3]); w[2] = pk2(v1[0], v1[1]); w[3] = pk2(v1[2], v1[3]);
                    *(u32x4*)(rowp + bj * 128) = w; } }
    } };
template <bool ADD> struct EpiMix { static constexpr bool PERM = true, AFTER_DRAIN = false; bf16_t* MIX; const bf16_t* gate;
    DI void operator()(const pg8::f32x4 (&acc)[2][2][4][2], const pg8::Unit& u, int wr, int wc, int fr, int fq) const {
        const int row0 = u.pm * 256 + wr * 64 + fr, col0 = u.pn * 256 + wc * 32 + 8 * fq;
#pragma unroll
        for (int ai = 0; ai < 2; ++ai)
#pragma unroll
            for (int m = 0; m < 4; ++m) { const int row = row0 + ai * 128 + m * 16;
#pragma unroll
                for (int bj = 0; bj < 2; ++bj) { const pg8::f32x4 v0 = acc[ai][bj][m][0], v1 = acc[ai][bj][m][1];
                    const u32x4 gt = *(const u32x4*)(gate + (size_t)row * NP + col0 + bj * 128);
                    float o[8] = {v0[0], v0[1], v0[2], v0[3], v1[0], v1[1], v1[2], v1[3]};
#pragma unroll
                    for (int j = 0; j < 4; ++j) { o[2 * j] *= sigm(bflo(gt[j])); o[2 * j + 1] *= sigm(bfhi(gt[j])); }
                    bf16_t* dp = MIX + (size_t)row * DM + col0 + bj * 128;
                    if (ADD) { const u32x4 pr = *(const u32x4*)dp;
#pragma unroll
                        for (int j = 0; j < 4; ++j) { o[2 * j] += bflo(pr[j]); o[2 * j + 1] += bfhi(pr[j]); } }
                    u32x4 w; w[0] = pk2(o[0], o[1]); w[1] = pk2(o[2], o[3]); w[2] = pk2(o[4], o[5]); w[3] = pk2(o[6], o[7]);
                    *(u32x4*)dp = w; } }
    } };
struct EpiRes { static constexpr bool PERM = false, AFTER_DRAIN = false; float* C; const float* R;
    DI void operator()(const pg8::f32x4 (&acc)[2][2][4][2], const pg8::Unit& u, int wr, int wc, int fr, int fq) const {
        const int row0 = u.pm * 256 + wr * 64 + fr, col0 = u.pn * 256 + wc * 32 + 4 * fq;
#pragma unroll
        for (int ai = 0; ai < 2; ++ai)
#pragma unroll
            for (int m = 0; m < 4; ++m) { const size_t ro = (size_t)(row0 + ai * 128 + m * 16) * DM + col0;
#pragma unroll
                for (int bj = 0; bj < 2; ++bj)
#pragma unroll
                    for (int n = 0; n < 2; ++n) { const pg8::f32x4 rv = *(const pg8::f32x4*)(R + ro + bj * 128 + n * 16); *(pg8::f32x4*)(C + ro + bj * 128 + n * 16) = acc[ai][bj][m][n] + rv; } }
    } };
struct EpiGU { static constexpr bool PERM = true, AFTER_DRAIN = false; bf16_t* ACT;
    DI void operator()(const pg8::f32x4 (&acc)[2][2][4][2], const pg8::Unit& u, int wr, int wc, int fr, int fq) const {
        const int row0 = u.pm * 256 + wr * 64 + fr, col0 = u.pn * 128 + wc * 32 + 8 * fq;
#pragma unroll
        for (int ai = 0; ai < 2; ++ai)
#pragma unroll
            for (int m = 0; m < 4; ++m) { const pg8::f32x4 g0 = acc[ai][0][m][0], g1 = acc[ai][0][m][1], u0 = acc[ai][1][m][0], u1 = acc[ai][1][m][1];
                u32x4 w; w[0] = pk2(silu(g0[0]) * u0[0], silu(g0[1]) * u0[1]); w[1] = pk2(silu(g0[2]) * u0[2], silu(g0[3]) * u0[3]);
                w[2] = pk2(silu(g1[0]) * u1[0], silu(g1[1]) * u1[1]); w[3] = pk2(silu(g1[2]) * u1[2], silu(g1[3]) * u1[3]);
                *(u32x4*)(ACT + (size_t)(row0 + ai * 128 + m * 16) * DFF + col0) = w; }
    } };
template <class Epi> DI void run_gemm(LAS unsigned char* lds, const bf16_t* A, const bf16_t* Bt, int M, int N, int K, const Epi& E) {
    pg8::Gemm g{A, Bt, M, N, K}; pg8::StaticOrder S; S.init(M, N, (int)gridDim.x, (int)blockIdx.x);
    pg8::gemm_phase<Epi, pg8::StaticOrder, false>((PG8_LAS unsigned char*)lds, g, S, E, nullptr);
    __syncthreads();
}

DI void qk_norm_item(bf16_t* PROJ, const float* qg, const float* kg, int item, int tid) {
    const int w = tid >> 6, lane = tid & 63, sub = lane & 15, vq = lane >> 4;
#pragma unroll 1
    for (int tt = 0; tt < 2; ++tt) {
        const int tok = item * 16 + w * 2 + tt;
#pragma unroll 1
        for (int it = 0; it < 6; ++it) {
            const int vi = it * 4 + vq;
            int col; const float* gn; float sc = 1.0f;
            if (vi < 16) { col = vi * 128; gn = qg; sc = QSCALE; }
            else if (vi < 20) { col = C_KV + (8 + (vi - 16)) * 128; gn = kg + 128; }
            else { col = C_KV + (16 + (vi - 20)) * 128; gn = kg + 256; }
            bf16_t* p = PROJ + (size_t)tok * NP + col + sub * 8;
            const u32x4 raw = *(const u32x4*)p; float v[8];
#pragma unroll
            for (int j = 0; j < 4; ++j) { v[2 * j] = bflo(raw[j]); v[2 * j + 1] = bfhi(raw[j]); }
            float ss = 0.f;
#pragma unroll
            for (int j = 0; j < 8; ++j) ss += v[j] * v[j];
            ss += __shfl_xor(ss, 1); ss += __shfl_xor(ss, 2); ss += __shfl_xor(ss, 4); ss += __shfl_xor(ss, 8);
            const float rs = rsqrtf(ss * (1.0f / 128.0f) + EPS) * sc;
            const f32x4 g0 = *(const f32x4*)(gn + sub * 8), g1 = *(const f32x4*)(gn + sub * 8 + 4);
            u32x4 o; o[0] = pk2(v[0] * rs * g0[0], v[1] * rs * g0[1]); o[1] = pk2(v[2] * rs * g0[2], v[3] * rs * g0[3]);
            o[2] = pk2(v[4] * rs * g1[0], v[5] * rs * g1[1]); o[3] = pk2(v[6] * rs * g1[2], v[7] * rs * g1[3]);
            *(u32x4*)p = o;
        }
    }
}
DI void cmp_item(LAS unsigned char* L, const bf16_t* PROJ, const bf16_t* WCT, const float* cmpc, const float* kgain, bf16_t* KC, bf16_t* VCT, int item, int tid) {
    const int rq = item & 3, kv = (item >> 2) & 1, g = (item >> 3) & 3, bl = item >> 5;
    const int w = tid >> 6, lane = tid & 63, c = lane & 31, hf = lane >> 5, mt = w & 1, et = w >> 1;
    int n = rq * 64 + mt * 32 + c; if (n > 254) n = 254;
    const bf16_t* ap = PROJ + (size_t)(bl * SEQ + 16 * n) * NP + C_KV + (kv * 4 + g) * 128 + hf * 8;
    const bf16_t* bp = WCT + (size_t)kv * 128 * 4096 + (size_t)(et * 32 + c) * 4096 + hf * 8;
    f32x16 acc = zero16();
#pragma unroll 1
    for (int l = 0; l < 32; ++l) {
#pragma unroll
        for (int ds = 0; ds < 8; ++ds) {
            const bf16x8 a = *(const bf16x8*)(ap + (size_t)l * NP + ds * 16);
            const bf16x8 b = *(const bf16x8*)(bp + l * 128 + ds * 16);
            acc = mfma32(a, b, acc);
        }
    }
    LAS float* st = (LAS float*)L;
    const int e = et * 32 + c; const float cc = cmpc[kv * 128 + e];
#pragma unroll
    for (int i = 0; i < 16; ++i) st[(mt * 32 + crow(i, hf)) * 129 + e] = acc[i] + cc;
    __syncthreads();
    if (kv == 0) {
#pragma unroll 1
        for (int rr = 0; rr < 8; ++rr) { const int row = w * 8 + rr, nn = rq * 64 + row;
            const float v0 = st[row * 129 + lane], v1 = st[row * 129 + lane + 64];
            const float ss = wsum(v0 * v0 + v1 * v1), rs = rsqrtf(ss * (1.0f / 128.0f) + EPS);
            bf16_t* d = KC + ((size_t)(bl * 256 + nn) * 4 + g) * 128;
            d[lane] = f2bf(v0 * rs * kgain[lane]); d[lane + 64] = f2bf(v1 * rs * kgain[lane + 64]); }
    } else {
        const int ee = tid >> 2, nc = (tid & 3) * 16; u32x4 o[2];
#pragma unroll
        for (int j = 0; j < 8; ++j) { const int r0 = nc + 2 * j; float a = st[r0 * 129 + ee], b = st[(r0 + 1) * 129 + ee];
            if (rq * 64 + r0 >= 255) a = 0.f; if (rq * 64 + r0 + 1 >= 255) b = 0.f; o[j >> 2][j & 3] = pk2(a, b); }
        bf16_t* d = VCT + ((size_t)(bl * 4 + g) * 128 + ee) * 256 + rq * 64 + nc;
        *(u32x4*)d = o[0]; *(u32x4*)(d + 8) = o[1];
    }
    __syncthreads();
}
DI void vt_item(LAS unsigned char* L, const bf16_t* PROJ, bf16_t* VT, int item, int tid) {
    const int tb = item & 63, g = (item >> 6) & 3, bl = (item >> 8) & 1, br = item >> 9;
    const bf16_t* src = PROJ + (size_t)(bl * SEQ + tb * 64) * NP + C_KV + (((br + 1) * 2 + 1) * 4 + g) * 128;
#pragma unroll
    for (int i = 0; i < 2; ++i) { const int c = tid + 512 * i, tok = c >> 4, part = c & 15;
        const u32x4 v = *(const u32x4*)(src + (size_t)tok * NP + part * 8);
        LAS u32x2* d = (LAS u32x2*)(L + tok * 264 + part * 16); d[0] = (u32x2){v[0], v[1]}; d[1] = (u32x2){v[2], v[3]}; }
    __syncthreads();
    const int d = tid >> 2, tc = (tid & 3) * 16; u32x4 o[2];
#pragma unroll
    for (int j = 0; j < 8; ++j) { const unsigned a = *(LAS bf16_t*)(L + (tc + 2 * j) * 264 + d * 2), b = *(LAS bf16_t*)(L + (tc + 2 * j + 1) * 264 + d * 2); o[j >> 2][j & 3] = a | (b << 16); }
    bf16_t* dst = VT + ((size_t)((br * 2 + bl) * 4 + g) * 128 + d) * SEQ + tb * 64 + tc;
    *(u32x4*)dst = o[0]; *(u32x4*)(dst + 8) = o[1];
    __syncthreads();
}
constexpr int GP_QB = 0, GP_KB = 17408, GP_KGT = 34816, GP_KBGT = 53248, GP_VBT = 71680, GP_LM = 90112, GP_TB = 106752, GP_QKS = 115968, GP_GC = 125184, GP_BETA = 125440;
DI void gdn_prep_item(LAS unsigned char* L, const bf16_t* PROJ, const float* convw, const float* a_log, const float* dt_bias,
                      bf16_t* GQG, bf16_t* GKGT, bf16_t* GW, bf16_t* GUT, bf16_t* GQK, float* GEXP, int unit, int tid) {
    const int h = unit & 15, n = (unit >> 4) & 63, bl = unit >> 10;
    const int w = tid >> 6, lane = tid & 63, c = lane & 31, hf = lane >> 5;
    LAS float* gcs = (LAS float*)(L + GP_GC); LAS float* betas = (LAS float*)(L + GP_BETA);
    const bf16_t* base = PROJ + (size_t)(bl * SEQ) * NP;
    if (w == 0) {
        const size_t tok = (size_t)(n * 64 + lane);
        const float av = bf2f(base[tok * NP + C_A + h]), bv = bf2f(base[tok * NP + C_B + h]);
        const float xs = av + dt_bias[h]; const float sp = xs > 20.f ? xs : log1pf(__expf(xs));
        float gv = -__expf(a_log[h]) * sp;
#pragma unroll
        for (int o = 1; o < 64; o <<= 1) { const float t = __shfl_up(gv, o); if (lane >= o) gv += t; }
        gcs[lane] = gv; betas[lane] = sigm(bv);
    }
    __syncthreads();
    const float glast = gcs[63];
    {
        const int sl0 = n * 64 + w * 8;
        unsigned raw[3][11]; float cw[3][4][2];
#pragma unroll
        for (int wh = 0; wh < 3; ++wh) { const int col = C_GQ + wh * 2048 + h * 128 + 2 * lane;
#pragma unroll
            for (int r = 0; r < 11; ++r) { const int sl = sl0 - 3 + r; raw[wh][r] = (sl >= 0) ? *(const unsigned*)(base + (size_t)sl * NP + col) : 0u; }
#pragma unroll
            for (int i = 0; i < 4; ++i) { const f2_t cv = *(const f2_t*)(convw + (size_t)i * 6144 + wh * 2048 + h * 128 + 2 * lane); cw[wh][i][0] = cv[0]; cw[wh][i][1] = cv[1]; } }
        float pkg[2], pkbg[2], pvb[2];
#pragma unroll
        for (int tt = 0; tt < 8; ++tt) {
            float y[3][2];
#pragma unroll
            for (int wh = 0; wh < 3; ++wh) { float a0 = 0.f, a1 = 0.f;
#pragma unroll
                for (int i = 0; i < 4; ++i) { a0 += cw[wh][i][0] * bflo(raw[wh][tt + i]); a1 += cw[wh][i][1] * bfhi(raw[wh][tt + i]); }
                y[wh][0] = silu(a0); y[wh][1] = silu(a1); }
            const float ssq = wsum(y[0][0] * y[0][0] + y[0][1] * y[0][1]), ssk = wsum(y[1][0] * y[1][0] + y[1][1] * y[1][1]);
            const float qs = rsqrtf(ssq + EPS) * 0.08838834764831845f, ks = rsqrtf(ssk + EPS);
            const int t = w * 8 + tt; const float gct = gcs[t], bt = betas[t], eg = __expf(gct), ek = __expf(glast - gct);
            const float q0 = y[0][0] * qs, q1 = y[0][1] * qs, k0 = y[1][0] * ks, k1 = y[1][1] * ks;
            *(LAS unsigned*)(L + GP_QB + (t * 136 + 2 * lane) * 2) = pk2(q0, q1);
            *(LAS unsigned*)(L + GP_KB + (t * 136 + 2 * lane) * 2) = pk2(k0, k1);
            *(unsigned*)(GQG + (size_t)unit * 8192 + t * 128 + 2 * lane) = pk2(q0 * eg, q1 * eg);
            const float kg0 = k0 * ek, kg1 = k1 * ek, kb0 = k0 * bt * eg, kb1 = k1 * bt * eg, vb0 = y[2][0] * bt, vb1 = y[2][1] * bt;
            if (tt & 1) {
                *(LAS unsigned*)(L + GP_KGT + ((2 * lane) * 72 + t - 1) * 2) = pk2(pkg[0], kg0); *(LAS unsigned*)(L + GP_KGT + ((2 * lane + 1) * 72 + t - 1) * 2) = pk2(pkg[1], kg1);
                *(LAS unsigned*)(L + GP_KBGT + ((2 * lane) * 72 + t - 1) * 2) = pk2(pkbg[0], kb0); *(LAS unsigned*)(L + GP_KBGT + ((2 * lane + 1) * 72 + t - 1) * 2) = pk2(pkbg[1], kb1);
                *(LAS unsigned*)(L + GP_VBT + ((2 * lane) * 72 + t - 1) * 2) = pk2(pvb[0], vb0); *(LAS unsigned*)(L + GP_VBT + ((2 * lane + 1) * 72 + t - 1) * 2) = pk2(pvb[1], vb1);
            } else { pkg[0] = kg0; pkg[1] = kg1; pkbg[0] = kb0; pkbg[1] = kb1; pvb[0] = vb0; pvb[1] = vb1; }
        }
    }
    __syncthreads();
    {
        const int which = w >> 2, ti = (w >> 1) & 1, tj = w & 1;
        f32x16 acc = zero16();
        if (ti >= tj) {
#pragma unroll
            for (int s = 0; s < 8; ++s) {
                const bf16x8 a = *(const LAS bf16x8*)(L + (which ? GP_QB : GP_KB) + ((ti * 32 + c) * 136 + 16 * s + 8 * hf) * 2);
                const bf16x8 b = *(const LAS bf16x8*)(L + GP_KB + ((tj * 32 + c) * 136 + 16 * s + 8 * hf) * 2);
                acc = mfma32(a, b, acc);
            }
        }
        const int j = tj * 32 + c; const float gj = gcs[j];
#pragma unroll
        for (int r = 0; r < 16; ++r) { const int i = ti * 32 + crow(r, hf); const float gi = gcs[i];
            if (which == 0) { const float v = (i > j) ? betas[i] * acc[r] * __expf(gi - gj) : 0.f; *(LAS float*)(L + GP_LM + (i * 65 + j) * 4) = v; }
            else { const float v = (i >= j) ? acc[r] * __expf(gi - gj) : 0.f; *(LAS bf16_t*)(L + GP_QKS + (i * 72 + j) * 2) = f2bf(v); } }
    }
    __syncthreads();
    {
        const int mp = lane & 7, j = 8 * w + (lane >> 3); float xr[8];
#pragma unroll
        for (int k = 0; k < 8; ++k) xr[k] = 0.f;
        const LAS float* Lm = (const LAS float*)(L + GP_LM);
#pragma unroll
        for (int i = 0; i < 64; ++i) {
            float a = 0.f;
#pragma unroll
            for (int k = 0; k < 8; ++k) if (8 * k < i) a += Lm[i * 65 + 8 * k + mp] * xr[k];
            a += __shfl_xor(a, 1); a += __shfl_xor(a, 2); a += __shfl_xor(a, 4);
            const float x = ((i == j) ? 1.f : 0.f) - a;
            if (mp == (i & 7)) xr[i >> 3] = x;
        }
#pragma unroll
        for (int k = 0; k < 8; ++k) *(LAS bf16_t*)(L + GP_TB + ((8 * k + mp) * 72 + j) * 2) = f2bf(xr[k]);
    }
    __syncthreads();
    {
        const int mt = w & 1, dt = w >> 1; f32x16 au = zero16(), aw = zero16();
#pragma unroll
        for (int s = 0; s < 4; ++s) {
            const bf16x8 tb = *(const LAS bf16x8*)(L + GP_TB + ((mt * 32 + c) * 72 + 16 * s + 8 * hf) * 2);
            const bf16x8 vb = *(const LAS bf16x8*)(L + GP_VBT + ((dt * 32 + c) * 72 + 16 * s + 8 * hf) * 2);
            const bf16x8 kb = *(const LAS bf16x8*)(L + GP_KBGT + ((dt * 32 + c) * 72 + 16 * s + 8 * hf) * 2);
            au = mfma32(tb, vb, au); aw = mfma32(kb, tb, aw);
        }
#pragma unroll
        for (int q = 0; q < 4; ++q) {
            *(u32x2*)(GUT + (size_t)unit * 8192 + (dt * 32 + c) * 64 + mt * 32 + 8 * q + 4 * hf) = (u32x2){pk2(au[4 * q], au[4 * q + 1]), pk2(au[4 * q + 2], au[4 * q + 3])};
            *(u32x2*)(GW + (size_t)unit * 8192 + (mt * 32 + c) * 128 + dt * 32 + 8 * q + 4 * hf) = (u32x2){pk2(aw[4 * q], aw[4 * q + 1]), pk2(aw[4 * q + 2], aw[4 * q + 3])};
        }
#pragma unroll
        for (int i = 0; i < 2; ++i) { const int cc = tid + 512 * i, d = cc >> 3, part = cc & 7;
            *(u32x4*)(GKGT + (size_t)unit * 8192 + d * 64 + part * 8) = *(const LAS u32x4*)(L + GP_KGT + (d * 72 + part * 8) * 2); }
        { const int r = tid >> 3, part = tid & 7; *(u32x4*)(GQK + (size_t)unit * 4096 + r * 64 + part * 8) = *(const LAS u32x4*)(L + GP_QKS + (r * 72 + part * 8) * 2); }
        if (tid == 0) GEXP[unit] = __expf(glast);
    }
    __syncthreads();
}

DI void cmp_attn_item(LAS unsigned char* L, const bf16_t* PROJ, const bf16_t* KC, const bf16_t* VCT, bf16_t* OA, unsigned* SEL, int item, int tid) {
    const int qb = 63 - (item & 63), g = (item >> 6) & 3, bl = item >> 8;
    const int w = tid >> 6, lane = tid & 63, c = lane & 31, hf = lane >> 5;
    const int tl = w * 8 + (c >> 2), r = c & 3, t = qb * 64 + tl, tok = bl * SEQ + t, h = g * 4 + r;
    bf16x8 qf[8];
#pragma unroll
    for (int s = 0; s < 8; ++s) qf[s] = *(const bf16x8*)(PROJ + (size_t)tok * NP + h * 128 + 16 * s + 8 * hf);
    const int ntile = (4 * qb + 34) >> 5, nvalid = t >= 31 ? ((t - 31) >> 4) + 1 : 0;
    const bf16_t* kcb = KC + ((size_t)(bl * 256 + c) * 4 + g) * 128 + 8 * hf;
    const bf16_t* vcb = VCT + ((size_t)(bl * 4 + g) * 128 + c) * 256 + 4 * hf;
    float m = -1e30f;
#pragma unroll
    for (int tau = 0; tau < 8; ++tau) if (tau < ntile) {
        f32x16 acc = zero16();
#pragma unroll
        for (int s = 0; s < 8; ++s) acc = mfma32(*(const bf16x8*)(kcb + (size_t)tau * 32 * 512 + 16 * s), qf[s], acc);
#pragma unroll
        for (int i = 0; i < 16; ++i) { const int n = 32 * tau + crow(i, hf); if (n < nvalid) m = fmaxf(m, acc[i]); }
    }
    m = fmaxf(m, __shfl_xor(m, 32));
    LAS float* Lv = (LAS float*)L + tid; float lsum = 0.f, Elast = 0.f; f32x16 O[4];
#pragma unroll
    for (int d = 0; d < 4; ++d) O[d] = zero16();
#pragma unroll
    for (int tau = 0; tau < 8; ++tau) {
        if (tau < ntile) {
            f32x16 acc = zero16();
#pragma unroll
            for (int s = 0; s < 8; ++s) acc = mfma32(*(const bf16x8*)(kcb + (size_t)tau * 32 * 512 + 16 * s), qf[s], acc);
#pragma unroll
            for (int i = 0; i < 16; ++i) { const int n = 32 * tau + crow(i, hf); const float p = (n < nvalid) ? exp2f(acc[i] - m) : 0.f; acc[i] = p; lsum += p; }
#pragma unroll
            for (int a = 0; a < 4; ++a) { const float Wq = acc[4 * a] + acc[4 * a + 1] + acc[4 * a + 2] + 0.5f * acc[4 * a + 3], Eq = 0.5f * acc[4 * a + 3];
                const float ep_same = __shfl_xor(Eq, 32), ep_prev = __shfl_xor(Elast, 32);
                Lv[(tau * 4 + a) * 512] = Wq + (hf ? ep_same : ep_prev); Elast = Eq; }
#pragma unroll
            for (int s2 = 0; s2 < 2; ++s2) { const bf16x8 pf = pack8(acc, s2);
#pragma unroll
                for (int d = 0; d < 4; ++d) { const bf16_t* vp = vcb + (size_t)d * 32 * 256 + 32 * tau + 16 * s2;
                    O[d] = mfma32(cat8(*(const u32x2*)vp, *(const u32x2*)(vp + 8)), pf, O[d]); } }
        } else {
#pragma unroll
            for (int a = 0; a < 4; ++a) Lv[(tau * 4 + a) * 512] = 0.f;
        }
    }
    lsum += __shfl_xor(lsum, 32);
    const float inv = lsum > 0.f ? 1.0f / lsum : 0.f;
    {
        const float g0 = sigm(bf2f(PROJ[(size_t)tok * NP + C_GATE + h * 3 + 0])) * inv;
#pragma unroll
        for (int d = 0; d < 4; ++d)
#pragma unroll
            for (int q = 0; q < 4; ++q) *(u32x2*)(OA + (size_t)tok * DM + h * 128 + d * 32 + 8 * q + 4 * hf) = (u32x2){pk2(O[d][4 * q] * g0, O[d][4 * q + 1] * g0), pk2(O[d][4 * q + 2] * g0, O[d][4 * q + 3] * g0)};
    }
    float V[32], ps[32];
#pragma unroll
    for (int q = 0; q < 32; ++q) {
        float v = Lv[q * 512] * inv; v += __shfl_xor(v, 1); v += __shfl_xor(v, 2);
        const int j = 2 * q + hf; const bool forced = (j == 0) | (j == qb) | (j == qb - 1), causal = j <= qb;
        V[q] = forced ? 1e4f : (causal ? v : -1e4f);
    }
#pragma unroll
    for (int q = 0; q < 32; ++q) ps[q] = __shfl_xor(V[q], 32);
    unsigned lo = 0u, hi = 0u;
#pragma unroll
    for (int q = 0; q < 32; ++q) {
        int cnt = 0; const float s = V[q];
#pragma unroll
        for (int q2 = 0; q2 < 32; ++q2) {
            if (q2 < q) { cnt += (V[q2] >= s) ? 1 : 0; cnt += (ps[q2] >= s) ? 1 : 0; }
            else if (q2 == q) { cnt += hf ? ((ps[q2] >= s) ? 1 : 0) : ((ps[q2] > s) ? 1 : 0); }
            else { cnt += (V[q2] > s) ? 1 : 0; cnt += (ps[q2] > s) ? 1 : 0; }
        }
        const int j = 2 * q + hf; const bool sel = (cnt < 16) && (j <= qb);
        if (q < 16) lo |= sel ? (1u << (2 * q + hf)) : 0u; else hi |= sel ? (1u << (2 * (q - 16) + hf)) : 0u;
    }
    lo |= __shfl_xor(lo, 32); hi |= __shfl_xor(hi, 32);
    if (r == 0 && hf == 0) *(u32x2*)(SEL + ((size_t)tok * 4 + g) * 2) = (u32x2){lo, hi};
}

constexpr int AT_K = 0, AT_V = 34816, AT_MISC = 69632;
DI void at_load(const bf16_t* Kg, const bf16_t* VTg, int j, int tid, u32x4 (&kr)[2], u32x4 (&vr)[2]) {
#pragma unroll
    for (int i = 0; i < 2; ++i) { const int cc = tid + 512 * i; kr[i] = *(const u32x4*)(Kg + (size_t)(j * 64 + (cc >> 4)) * NP + (cc & 15) * 8); vr[i] = *(const u32x4*)(VTg + (size_t)(cc >> 3) * SEQ + j * 64 + (cc & 7) * 8); }
}
DI void at_store(LAS unsigned char* L, int buf, int tid, const u32x4 (&kr)[2], const u32x4 (&vr)[2]) {
#pragma unroll
    for (int i = 0; i < 2; ++i) { const int cc = tid + 512 * i;
        *(LAS u32x4*)(L + AT_K + buf * 17408 + (cc >> 4) * 272 + (cc & 15) * 16) = kr[i];
        LAS u32x2* d = (LAS u32x2*)(L + AT_V + buf * 17408 + (cc >> 3) * 136 + (cc & 7) * 16); d[0] = (u32x2){vr[i][0], vr[i][1]}; d[1] = (u32x2){vr[i][2], vr[i][3]}; }
}
DI int at_next(int j, int qb, u64 um) { for (++j; j <= qb; ++j) if ((um >> j) & 1ull) break; return j; }
template <int MODE> DI void attn_pass(LAS unsigned char* L, const bf16_t* Kg, const bf16_t* VTg, int qb, u64 selm, u64 um, int tl64, const bf16x8 (&qf)[8],
                                      f32x16 (&O)[4], float& lsum, int tid) {
    const int lane = tid & 63, c = lane & 31, hf = lane >> 5;
    float m = -1e30f; lsum = 0.f;
#pragma unroll
    for (int d = 0; d < 4; ++d) O[d] = zero16();
    int j = at_next((MODE ? (qb > 8 ? qb - 8 : 0) : 0) - 1, qb, um), buf = 0;
    u32x4 kr[2], vr[2];
    if (j <= qb) { at_load(Kg, VTg, j, tid, kr, vr); at_store(L, 0, tid, kr, vr); }
    __syncthreads();
    while (j <= qb) {
        const int jn = at_next(j, qb, um);
        if (jn <= qb) at_load(Kg, VTg, jn, tid, kr, vr);
        {
            const LAS unsigned char* Kt = L + AT_K + buf * 17408; const LAS unsigned char* Vt = L + AT_V + buf * 17408;
            f32x16 s0 = zero16(), s1 = zero16();
#pragma unroll
            for (int s = 0; s < 8; ++s) s0 = mfma32(*(const LAS bf16x8*)(Kt + c * 272 + (16 * s + 8 * hf) * 2), qf[s], s0);
#pragma unroll
            for (int s = 0; s < 8; ++s) s1 = mfma32(*(const LAS bf16x8*)(Kt + (32 + c) * 272 + (16 * s + 8 * hf) * 2), qf[s], s1);
            const bool diag = (j == qb), first = MODE ? (j == qb - 8) : false, selb = MODE ? true : (((selm >> j) & 1ull) != 0ull);
            float mx = m;
#pragma unroll
            for (int i = 0; i < 16; ++i) { const int k0 = crow(i, hf), k1 = 32 + k0;
                const bool v0 = selb && (diag ? (k0 <= tl64) : (first ? (k0 > tl64) : true)), v1 = selb && (diag ? (k1 <= tl64) : (first ? (k1 > tl64) : true));
                s0[i] = v0 ? s0[i] : -1e30f; s1[i] = v1 ? s1[i] : -1e30f; mx = fmaxf(mx, fmaxf(s0[i], s1[i])); }
            mx = fmaxf(mx, __shfl_xor(mx, 32));
            const float alpha = exp2f(m - mx); m = mx; float ps = 0.f;
#pragma unroll
            for (int i = 0; i < 16; ++i) { const float p0 = s0[i] > -1e29f ? exp2f(s0[i] - mx) : 0.f, p1 = s1[i] > -1e29f ? exp2f(s1[i] - mx) : 0.f; s0[i] = p0; s1[i] = p1; ps += p0 + p1; }
            lsum = lsum * alpha + ps;
#pragma unroll
            for (int d = 0; d < 4; ++d)
#pragma unroll
                for (int i = 0; i < 16; ++i) O[d][i] *= alpha;
#pragma unroll
            for (int s2 = 0; s2 < 2; ++s2) { const bf16x8 p0 = pack8(s0, s2), p1 = pack8(s1, s2);
#pragma unroll
                for (int d = 0; d < 4; ++d) { const LAS unsigned char* vp = Vt + (d * 32 + c) * 136 + (16 * s2 + 4 * hf) * 2;
                    O[d] = mfma32(cat8(*(const LAS u32x2*)vp, *(const LAS u32x2*)(vp + 16)), p0, O[d]);
                    O[d] = mfma32(cat8(*(const LAS u32x2*)(vp + 64), *(const LAS u32x2*)(vp + 80)), p1, O[d]); } }
        }
        if (jn <= qb) at_store(L, buf ^ 1, tid, kr, vr);
        __syncthreads();
        buf ^= 1; j = jn;
    }
    lsum += __shfl_xor(lsum, 32);
}
DI void attn_item(LAS unsigned char* L, const bf16_t* PROJ, const bf16_t* VT, const unsigned* SEL, bf16_t* OA, int item, int tid) {
    const int qb = 63 - (item & 63), g = (item >> 6) & 3, bl = item >> 8;
    const int w = tid >> 6, lane = tid & 63, c = lane & 31, hf = lane >> 5;
    const int tl64 = w * 8 + (c >> 2), r = c & 3, tok = bl * SEQ + qb * 64 + tl64, h = g * 4 + r;
    bf16x8 qf[8];
#pragma unroll
    for (int s = 0; s < 8; ++s) qf[s] = *(const bf16x8*)(PROJ + (size_t)tok * NP + h * 128 + 16 * s + 8 * hf);
    const u32x2 sm = *(const u32x2*)(SEL + ((size_t)tok * 4 + g) * 2);
    const u64 selm = (u64)sm[0] | ((u64)sm[1] << 32);
    unsigned ulo = sm[0], uhi = sm[1];
#pragma unroll
    for (int o = 1; o < 64; o <<= 1) { ulo |= __shfl_xor(ulo, o); uhi |= __shfl_xor(uhi, o); }
    LAS unsigned* misc = (LAS unsigned*)(L + AT_MISC);
    if (lane == 0) { misc[2 * w] = ulo; misc[2 * w + 1] = uhi; }
    __syncthreads();
    unsigned alo = 0u, ahi = 0u;
#pragma unroll
    for (int i = 0; i < 8; ++i) { alo |= misc[2 * i]; ahi |= misc[2 * i + 1]; }
    const u64 um = (u64)alo | ((u64)ahi << 32);
    const float g1 = sigm(bf2f(PROJ[(size_t)tok * NP + C_GATE + h * 3 + 1])), g2 = sigm(bf2f(PROJ[(size_t)tok * NP + C_GATE + h * 3 + 2]));
    f32x16 O[4]; float lsum;
    const bf16_t* pb = PROJ + (size_t)(bl * SEQ) * NP;
#pragma unroll 1
    for (int pass = 0; pass < 2; ++pass) {
        if (pass == 0) attn_pass<0>(L, pb + C_KV + (8 + g) * 128, VT + (size_t)((0 * 2 + bl) * 4 + g) * 128 * SEQ, qb, selm, um, tl64, qf, O, lsum, tid);
        else attn_pass<1>(L, pb + C_KV + (16 + g) * 128, VT + (size_t)((1 * 2 + bl) * 4 + g) * 128 * SEQ, qb, ~0ull, ~0ull, tl64, qf, O, lsum, tid);
        const float f = lsum > 0.f ? (pass ? g2 : g1) / lsum : 0.f;
#pragma unroll
        for (int d = 0; d < 4; ++d)
#pragma unroll
            for (int q = 0; q < 4; ++q) { bf16_t* op = OA + (size_t)tok * DM + h * 128 + d * 32 + 8 * q + 4 * hf; const u32x2 pr = *(const u32x2*)op;
                const float a0 = bflo(pr[0]) + O[d][4 * q] * f, a1 = bfhi(pr[0]) + O[d][4 * q + 1] * f, a2 = bflo(pr[1]) + O[d][4 * q + 2] * f, a3 = bfhi(pr[1]) + O[d][4 * q + 3] * f;
                *(u32x2*)op = (u32x2){pk2(a0, a1), pk2(a2, a3)}; }
    }
}

DI void gdn_scan(LAS unsigned char* L, const bf16_t* GQG, const bf16_t* GKGT, const bf16_t* GW, bf16_t* GUT, const bf16_t* GQK, const float* GEXP, int su, int tid) {
    const int sl = su & 3, h = (su >> 2) & 15, bl = su >> 6;
    const int w = tid >> 6, lane = tid & 63, c = lane & 31, hf = lane >> 5;
    LAS float* P1 = (LAS float*)L; LAS float* OB = (LAS float*)(L + 32768);
    f32x16 st = zero16();
#pragma unroll 1
    for (int n = 0; n < 64; ++n) {
        const size_t unit = (size_t)((bl * 64 + n) * 16 + h);
        bf16x8 qg[2][2], kg[4], qk[2], sf[2]; f32x16 u[2];
        if (w < 4) {
            bf16x8 wf[2][2];
#pragma unroll
            for (int mt = 0; mt < 2; ++mt) {
#pragma unroll
                for (int s = 0; s < 2; ++s) { const size_t o = unit * 8192 + (size_t)(mt * 32 + c) * 128 + 32 * w + 16 * s + 4 * hf;
                    wf[mt][s] = cat8(*(const u32x2*)(GW + o), *(const u32x2*)(GW + o + 8)); qg[mt][s] = cat8(*(const u32x2*)(GQG + o), *(const u32x2*)(GQG + o + 8)); }
                { const size_t o = unit * 4096 + (size_t)(mt * 32 + c) * 64 + 16 * w + 4 * hf; qk[mt] = cat8(*(const u32x2*)(GQK + o), *(const u32x2*)(GQK + o + 8)); }
#pragma unroll
                for (int q = 0; q < 4; ++q) { const u32x2 uv = *(const u32x2*)(GUT + unit * 8192 + (size_t)(sl * 32 + c) * 64 + mt * 32 + 8 * q + 4 * hf);
                    u[mt][4 * q] = bflo(uv[0]); u[mt][4 * q + 1] = bfhi(uv[0]); u[mt][4 * q + 2] = bflo(uv[1]); u[mt][4 * q + 3] = bfhi(uv[1]); }
            }
#pragma unroll
            for (int s = 0; s < 4; ++s) { const size_t o = unit * 8192 + (size_t)(32 * w + c) * 64 + 16 * s + 4 * hf; kg[s] = cat8(*(const u32x2*)(GKGT + o), *(const u32x2*)(GKGT + o + 8)); }
            sf[0] = pack8(st, 0); sf[1] = pack8(st, 1);
#pragma unroll
            for (int mt = 0; mt < 2; ++mt) { f32x16 p = zero16(); p = mfma32(wf[mt][0], sf[0], p); p = mfma32(wf[mt][1], sf[1], p);
#pragma unroll
                for (int i = 0; i < 16; ++i) P1[((w * 2 + mt) * 16 + i) * 64 + lane] = p[i]; }
        }
        __syncthreads();
        if (w < 4) {
            const float eg = GEXP[unit];
            bf16x8 vf[2][2];
#pragma unroll
            for (int mt = 0; mt < 2; ++mt) {
#pragma unroll
                for (int i = 0; i < 16; ++i) { float sm = 0.f;
#pragma unroll
                    for (int w2 = 0; w2 < 4; ++w2) sm += P1[((w2 * 2 + mt) * 16 + i) * 64 + lane];
                    u[mt][i] -= sm; }
                vf[mt][0] = pack8(u[mt], 0); vf[mt][1] = pack8(u[mt], 1);
            }
            const bf16x8 vsel = (w == 0) ? vf[0][0] : (w == 1) ? vf[0][1] : (w == 2) ? vf[1][0] : vf[1][1];
#pragma unroll
            for (int mt = 0; mt < 2; ++mt) { f32x16 o = zero16(); o = mfma32(qg[mt][0], sf[0], o); o = mfma32(qg[mt][1], sf[1], o); o = mfma32(qk[mt], vsel, o);
#pragma unroll
                for (int i = 0; i < 16; ++i) OB[((w * 2 + mt) * 16 + i) * 64 + lane] = o[i]; }
#pragma unroll
            for (int i = 0; i < 16; ++i) st[i] *= eg;
#pragma unroll
            for (int s = 0; s < 4; ++s) st = mfma32(kg[s], vf[s >> 1][s & 1], st);
        }
        __syncthreads();
        {
            const int l2 = tid & 63, q = (tid >> 6) & 3, mt = tid >> 8; float o4[4];
#pragma unroll
            for (int e = 0; e < 4; ++e) { float sm = 0.f;
#pragma unroll
                for (int w2 = 0; w2 < 4; ++w2) sm += OB[((w2 * 2 + mt) * 16 + 4 * q + e) * 64 + l2];
                o4[e] = sm; }
            *(u32x2*)(GUT + unit * 8192 + (size_t)(sl * 32 + (l2 & 31)) * 64 + mt * 32 + 8 * q + 4 * (l2 >> 5)) = (u32x2){pk2(o4[0], o4[1]), pk2(o4[2], o4[3])};
        }
    }
    __syncthreads();
}
DI void obnorm_item(LAS unsigned char* L, const bf16_t* GUT, const bf16_t* PROJ, const float* ogain, bf16_t* OBm, int unit, int tid) {
    const int h = unit & 15, n = (unit >> 4) & 63, bl = unit >> 10, w = tid >> 6, lane = tid & 63;
#pragma unroll
    for (int i = 0; i < 2; ++i) { const int cc = tid + 512 * i, d = cc >> 3, part = cc & 7; const u32x4 v = *(const u32x4*)(GUT + (size_t)unit * 8192 + d * 64 + part * 8);
        LAS unsigned* dp = (LAS unsigned*)(L + d * 132 + part * 16); dp[0] = v[0]; dp[1] = v[1]; dp[2] = v[2]; dp[3] = v[3]; }
    __syncthreads();
    const float g0 = ogain[lane], g1 = ogain[lane + 64];
#pragma unroll 1
    for (int tt = 0; tt < 8; ++tt) { const int t = w * 8 + tt; const size_t tok = (size_t)(bl * SEQ + n * 64 + t);
        const float v0 = bf2f(*(const LAS bf16_t*)(L + lane * 132 + t * 2)), v1 = bf2f(*(const LAS bf16_t*)(L + (lane + 64) * 132 + t * 2));
        const float rs = rsqrtf(wsum(v0 * v0 + v1 * v1) * (1.0f / 128.0f) + EPS);
        const float z0 = bf2f(PROJ[tok * NP + C_Z + h * 128 + lane]), z1 = bf2f(PROJ[tok * NP + C_Z + h * 128 + lane + 64]);
        OBm[tok * DM + h * 128 + lane] = f2bf(v0 * rs * g0 * silu(z0)); OBm[tok * DM + h * 128 + lane + 64] = f2bf(v1 * rs * g1 * silu(z1)); }
    __syncthreads();
}

DI unsigned char* opq(unsigned char* q) { asm volatile("" : "+s"(q)); return q; }
#define WSB opq(p.ws)
#define DOB opq((unsigned char*)p.out)
#define WAT ((bf16_t*)(WSB + WS_WAT))
#define WBT ((bf16_t*)(WSB + WS_WBT))
#define WOT ((bf16_t*)(WSB + WS_WOT))
#define WCT ((bf16_t*)(WSB + WS_WCT))
#define CMPC ((float*)(WSB + WS_CMPC))
#define CTR ((unsigned*)(WSB + WS_CTR))
#define KC ((bf16_t*)(WSB + WS_KC))
#define VCT ((bf16_t*)(WSB + WS_VCT))
#define SEL ((unsigned*)(WSB + WS_SEL))
#define GEXP ((float*)(WSB + WS_GEXP))
#define H ((bf16_t*)(WSB + WS_H))
#define WINT ((bf16_t*)(WSB + WS_WINT))
#define GQG ((bf16_t*)(WSB + WS_GQG))
#define GKGT ((bf16_t*)(WSB + WS_GKGT))
#define GW ((bf16_t*)(WSB + WS_GW))
#define PROJ ((bf16_t*)(WSB + WS_PROJ))
#define GUT ((bf16_t*)(WSB + WS_GU))
#define GQK ((bf16_t*)(WSB + WS_GQK))
#define VT ((bf16_t*)(WSB + WS_VT))
#define X1 ((float*)(WSB + WS_X1))
#define H2 ((bf16_t*)(WSB + WS_H2))
#define WGT ((bf16_t*)(WSB + WS_WGT))
#define WDT ((bf16_t*)(WSB + WS_WDT))
#define ACT ((bf16_t*)(WSB + WS_ACT))
#define OA ((bf16_t*)(DOB + DO_OA))
#define OBm ((bf16_t*)(DOB + DO_OB))
#define MIX ((bf16_t*)(DOB + DO_MIX))

template <int PH> DI void run_phase(Params p, int half, LAS unsigned char* L) {
    const int tid = threadIdx.x, bid = blockIdx.x, G = gridDim.x;
    LAS float* tile = (LAS float*)L;
    if (PH == 0) {
        if (bid == 0 && tid < 8) CTR[tid] = 0u;
        xpose_all<0>(tile, p.in[11], 2048, 2048, WAT, tid, bid, G);
        xpose_all<0>(tile, p.in[12], 2048, 2048, WBT, tid, bid, G);
        xpose_all<0>(tile, p.in[13], 2048, 2048, WOT, tid, bid, G);
        xpose_all<0>(tile, p.in[6], 4096, 128, WCT, tid, bid, G);
        xpose_all<0>(tile, p.in[6] + 4096 * 128, 4096, 128, WCT + 128 * 4096, tid, bid, G);
        if (bid >= G - 2) {
            const int kv = bid - (G - 2), e = tid & 127, part = tid >> 7; float s = 0.f;
            const float* pos = p.in[5] + kv * 4096; const float* wc = p.in[6] + (size_t)kv * 4096 * 128;
            for (int k = part * 1024; k < part * 1024 + 1024; ++k) s += pos[k] * wc[(size_t)k * 128 + e];
            tile[tid] = s; __syncthreads();
            if (tid < 128) CMPC[kv * 128 + tid] = tile[tid] + tile[tid + 128] + tile[tid + 256] + tile[tid + 384];
            __syncthreads();
        }
    }
    if (PH == 1) {
        xpose_all<1>(tile, p.in[2], 2048, 17488, WINT, tid, bid, G);
        norm_rows(p.in[0] + (size_t)half * TH * DM, p.in[1], H, TH, tid, bid, G);
    }
    if (PH == 2) { EpiProj E{PROJ}; run_gemm(L, H, WINT, TH, NP, 2048, E); }
    if (PH == 3) for (int it = bid; it < 64; it += G) cmp_item(L, PROJ, WCT, CMPC, p.in[4], KC, VCT, it, tid);
    if (PH == 4) for (int it = bid; it < 2048; it += G) gdn_prep_item(L, PROJ, p.in[7], p.in[8], p.in[9], GQG, GKGT, GW, GUT, GQK, GEXP, it, tid);
    if (PH == 5) for (int it = bid; it < 1024 + 512; it += G) { if (it < 1024) vt_item(L, PROJ, VT, it, tid); else qk_norm_item(PROJ, p.in[3], p.in[4], it - 1024, tid); }
    if (PH == 6) for (int it = bid; it < 512; it += G) cmp_attn_item(L, PROJ, KC, VCT, OA, SEL, it, tid);
    if (PH == 7) { if (bid < 128) gdn_scan(L, GQG, GKGT, GW, GUT, GQK, GEXP, bid, tid); }
    if (PH == 8) for (;;) {
        LAS unsigned* qw = (LAS unsigned*)(L + AT_MISC + 64);
        if (tid == 0) *qw = atomicAdd(CTR + half, 1u);
        __syncthreads();
        const unsigned it = *qw;
        __syncthreads();
        if (it >= 512u) break;
        attn_item(L, PROJ, VT, SEL, OA, (int)it, tid);
    }
    if (PH == 9) for (int it = bid; it < 2048; it += G) obnorm_item(L, GUT, PROJ, p.in[10], OBm, it, tid);
    if (PH == 10) { EpiMix<false> E{MIX + (size_t)half * TH * DM, PROJ + C_MA}; run_gemm(L, OA, WAT, TH, 2048, 2048, E); }
    if (PH == 11) { EpiMix<true> E{MIX + (size_t)half * TH * DM, PROJ + C_MB}; run_gemm(L, OBm, WBT, TH, 2048, 2048, E); }
    if (PH == 12) {
        xpose_all<2>(tile, p.in[15], 2048, DFF, WGT, tid, bid, G);
        xpose_all<3>(tile, p.in[16], 2048, DFF, WGT, tid, bid, G);
        xpose_all<0>(tile, p.in[17], DFF, 2048, WDT, tid, bid, G);
    }
    if (PH == 13) { EpiRes E{X1, p.in[0]}; run_gemm(L, MIX, WOT, 2 * TH, 2048, 2048, E); }
    if (PH == 14) norm_rows(X1, p.in[14], H2, 2 * TH, tid, bid, G);
    if (PH == 15) { EpiGU E{ACT}; run_gemm(L, H2, WGT, 2 * TH, 2 * DFF, 2048, E); }
    if (PH == 16) { EpiRes E{p.out, X1}; run_gemm(L, ACT, WDT, 2 * TH, 2048, DFF, E); }
}
constexpr int NPH = 17;
template <int PH> __global__ void __launch_bounds__(512, 2) phase_k(Params p, int half) {
    extern __shared__ __attribute__((aligned(16))) unsigned char smem[];
    run_phase<PH>(p, half, (LAS unsigned char*)smem);
}
constexpr int LDS_BYTES = 132 * 1024;
template <int PH> static void launch_phase(const Params& p, int half, int grid, hipStream_t stream) {
    static bool attr = false;
    if (!attr) { (void)hipFuncSetAttribute((const void*)phase_k<PH>, hipFuncAttributeMaxDynamicSharedMemorySize, LDS_BYTES); attr = true; }
    hipLaunchKernelGGL(phase_k<PH>, dim3(grid), dim3(512), LDS_BYTES, stream, p, half);
}
extern "C" void kernel_launch(void* const* d_in, const int* in_sizes, int n_in, void* d_out, int out_size, void* d_ws, size_t ws_size, hipStream_t stream) {
    const int grid = 256;
    Params p{};
    for (int i = 0; i < 18; ++i) p.in[i] = (const float*)d_in[i];
    p.out = (float*)d_out; p.ws = (unsigned char*)d_ws;
    launch_phase<0>(p, 0, grid, stream);
    for (int half = 0; half < 2; ++half) {
        launch_phase<1>(p, half, grid, stream); launch_phase<2>(p, half, grid, stream); launch_phase<3>(p, half, grid, stream); launch_phase<4>(p, half, grid, stream);
        launch_phase<5>(p, half, grid, stream); launch_phase<6>(p, half, grid, stream); launch_phase<7>(p, half, grid, stream); launch_phase<8>(p, half, grid, stream);
        launch_phase<9>(p, half, grid, stream); launch_phase<10>(p, half, grid, stream); launch_phase<11>(p, half, grid, stream);
    }
    launch_phase<12>(p, 0, grid, stream); launch_phase<13>(p, 0, grid, stream); launch_phase<14>(p, 0, grid, stream); launch_phase<15>(p, 0, grid, stream); launch_phase<16>(p, 0, grid, stream);
}
```

```cpp
#include <hip/hip_runtime.h>
#include <hip/hip_cooperative_groups.h>
#include <cstdio>
namespace cg = cooperative_groups;
namespace pg8 {
#define PG8_LAS __attribute__((address_space(3)))
typedef unsigned short bf16_t;
typedef short bf16x8 __attribute__((ext_vector_type(8)));
typedef float f32x4 __attribute__((ext_vector_type(4)));
typedef unsigned u32x4 __attribute__((ext_vector_type(4)));
constexpr int BM = 256, BK = 64, HALF = 128, HTB = HALF * BK * 2  , STAGE_BYTES = 8 * HTB, NXCD = 8, WGM = 8;

__host__ __device__ __forceinline__ int lds_byte(int r, int c) { const int st = (r >> 4) * 2 + (c >> 5), rr = r & 15, cc = c & 31, ob = rr * 64 + cc * 2; return st * 1024 + (ob ^ (((ob >> 9) & 1) << 5)); }
__host__ __device__ __forceinline__ void stage_rc(int b, int& R, int& C) { const int st = b / 1024, sb = b % 1024, swz = sb ^ (((sb >> 9) & 1) << 5); R = (st >> 1) * 16 + swz / 64; C = (st & 1) * 32 + (swz % 64) / 2; }
__host__ __device__ __forceinline__ int perm32(int rho) { const int n = rho >> 4, i = rho & 15; return 8 * (i >> 2) + 4 * n + (i & 3); }

struct Unit { int pm, pn; };
struct Gemm { const bf16_t* A; const bf16_t* Bt; int M, N, K; };

struct StaticOrder {
    int nM, nN, nwg, G, c;
    __host__ __device__ void init(int M, int N, int G_, int c_) { nM = M / BM; nN = N / BM; nwg = nM * nN; G = G_; c = c_; }
    __host__ __device__ bool next(int i, Unit& u) const {
        const long L = (long)i * G + c; if (L >= nwg) return false;
        int wgid = (int)L; { const int q = nwg / NXCD, r = nwg % NXCD, xcd = wgid % NXCD, off = wgid / NXCD; wgid = (xcd < r ? xcd * (q + 1) : r * (q + 1) + (xcd - r) * q) + off; }
        const int nig = WGM * nN, gid = wgid / nig, fm = gid * WGM, gsz = (nM - fm) < WGM ? (nM - fm) : WGM;
        u.pm = fm + ((wgid % nig) % gsz); u.pn = (wgid % nig) / gsz; return true;
    }
    __device__ __forceinline__ void a_ready(const Unit&) const {}
    __device__ __forceinline__ void done(const Unit&) const {}
};
__device__ __forceinline__ unsigned cvt_pk_bf16(float lo, float hi) { unsigned r; asm volatile("v_cvt_pk_bf16_f32 %0, %1, %2" : "=v"(r) : "v"(lo), "v"(hi)); return r; }

template <class Epi, class Sched, bool STAMP = false>
__device__ __forceinline__ void gemm_phase(PG8_LAS unsigned char* lds, const Gemm g, const Sched& S, const Epi& E, unsigned long long* stamps) {
    int tid_ = threadIdx.x; asm volatile("" : "+v"(tid_));
    const int tid = tid_, wid = __builtin_amdgcn_readfirstlane(tid >> 6), lane = tid & 63, wr = wid >> 2, wc = wid & 3, fr = lane & 15, fq = lane >> 4;
    const int K = g.K, nt = K / BK;
    int ts_lo = 0, ts_hi = 0, nts = 0; const unsigned long long rt_entry = STAMP ? (unsigned long long)wall_clock64() : 0ull;
#define PG8_STAMP() do { if (STAMP && wid == 0 && nts < 64) { const unsigned long long _c = (unsigned long long)clock64(); \
        ts_lo = (lane == nts) ? (int)(unsigned)_c : ts_lo; ts_hi = (lane == nts) ? (int)(unsigned)(_c >> 32) : ts_hi; ++nts; } } while (0)
    PG8_STAMP();
    unsigned voffA[2], voffB[2];
#pragma unroll
    for (int i = 0; i < 2; ++i) { int R, C; stage_rc(tid * 16 + i * 8192, R, C); const int Rb = Epi::PERM ? ((R & ~31) + perm32(R & 31)) : R;
        voffA[i] = (unsigned)(R * K + C) * 2u; voffB[i] = (unsigned)(Rb * K + C) * 2u; }
    const size_t kstep = (size_t)(BK * 2);
    const size_t hstep = (size_t)HALF * K * 2;
    const size_t tstep = 2 * hstep;
    const unsigned ldsw = (unsigned)wid * 1024u;
    const int aoff = lds_byte(wr * 64 + fr, fq * 8), boff = lds_byte(wc * 32 + fr, fq * 8);
#define PG8_SA(b, h) (((b) * 2 + (h)) * HTB)
#define PG8_SB(b, h) ((4 + (b) * 2 + (h)) * HTB)
#define PG8_STAGE(bufoff, gbase, voff) do { _Pragma("unroll") for (int _i = 0; _i < 2; ++_i) \
        __builtin_amdgcn_global_load_lds((const unsigned*)((const char*)(gbase) + (voff)[_i]), (PG8_LAS unsigned*)(lds + (bufoff) + ldsw + _i * 8192), 16, 0, 0); } while (0)
#define PG8_LDA(dst, b, h) do { _Pragma("unroll") for (int m = 0; m < 4; ++m) _Pragma("unroll") for (int k = 0; k < 2; ++k) dst[m][k] = *(const PG8_LAS bf16x8*)(lds + PG8_SA(b, h) + aoff + m * 2048 + k * 1024); } while (0)
#define PG8_LDB(dst, b, h) do { _Pragma("unroll") for (int n = 0; n < 2; ++n) _Pragma("unroll") for (int k = 0; k < 2; ++k) dst[n][k] = *(const PG8_LAS bf16x8*)(lds + PG8_SB(b, h) + boff + n * 2048 + k * 1024); } while (0)
#define PG8_MMA(ai, bj, At, Bt) do { __builtin_amdgcn_s_setprio(1); _Pragma("unroll") for (int m = 0; m < 4; ++m) _Pragma("unroll") for (int n = 0; n < 2; ++n) _Pragma("unroll") for (int k = 0; k < 2; ++k) \
        acc[ai][bj][m][n] = __builtin_amdgcn_mfma_f32_16x16x32_bf16(Bt[n][k], At[m][k], acc[ai][bj][m][n], 0, 0, 0); __builtin_amdgcn_s_setprio(0); } while (0)
#define PG8_WAIT_V(n) asm volatile("s_waitcnt vmcnt(" #n ")" ::: "memory")
#define PG8_WAIT_L(n) asm volatile("s_waitcnt lgkmcnt(" #n ")" ::: "memory")
#define PG8_BAR __builtin_amdgcn_s_barrier()
#define PG8_SCHED __builtin_amdgcn_sched_barrier(0)
    Unit cur, nxt; int ui = 0;
    if (!S.next(0, cur)) return;
    f32x4 acc[2][2][4][2];
#pragma unroll
    for (int a = 0; a < 2; ++a)
#pragma unroll
        for (int b = 0; b < 2; ++b)
#pragma unroll
            for (int m = 0; m < 4; ++m)
#pragma unroll
                for (int n = 0; n < 2; ++n) acc[a][b][m][n] = (f32x4){0.f, 0.f, 0.f, 0.f};
    bf16x8 At[4][2], B0[2][2], B1[2][2];
    const char* cA = (const char*)g.A + (size_t)cur.pm * tstep; const char* cB = (const char*)g.Bt + (size_t)cur.pn * tstep;
    S.a_ready(cur);
    PG8_STAGE(PG8_SB(0, 0), cB, voffB); PG8_STAGE(PG8_SA(0, 0), cA, voffA); PG8_STAGE(PG8_SB(0, 1), cB + hstep, voffB); PG8_STAGE(PG8_SA(0, 1), cA + hstep, voffA);
    if (wr == 1) PG8_BAR;
    PG8_WAIT_V(4); PG8_BAR;
    PG8_STAGE(PG8_SB(1, 0), cB + kstep, voffB); PG8_STAGE(PG8_SA(1, 0), cA + kstep, voffA); PG8_STAGE(PG8_SB(1, 1), cB + hstep + kstep, voffB);
    PG8_WAIT_V(6); PG8_BAR;
    PG8_STAMP();
    for (;;) {
        const bool has_next = S.next(ui + 1, nxt);
        const char* nA = has_next ? (const char*)g.A + (size_t)nxt.pm * tstep : cA; const char* nB = has_next ? (const char*)g.Bt + (size_t)nxt.pn * tstep : cB;
        for (int t = 0; t < nt; t += 2) {
            const bool last = (t == nt - 2);
            const char* a1 = cA + (size_t)(t + 1) * kstep;
            const char* a2 = last ? nA : cA + (size_t)(t + 2) * kstep; const char* b2 = last ? nB : cB + (size_t)(t + 2) * kstep;
            const char* a3 = a2 + kstep; const char* b3 = b2 + kstep;
            if (last && has_next) S.a_ready(nxt);
            PG8_LDB(B0, 0, 0); PG8_SCHED; PG8_LDA(At, 0, 0); PG8_STAGE(PG8_SA(1, 1), a1 + hstep, voffA);
            PG8_WAIT_L(8); PG8_BAR; PG8_WAIT_L(0); PG8_MMA(0, 0, At, B0); PG8_BAR; PG8_SCHED;
            PG8_LDB(B1, 0, 1); PG8_STAGE(PG8_SB(0, 0), b2, voffB);
            PG8_BAR; PG8_WAIT_L(0); PG8_MMA(0, 1, At, B1); PG8_BAR;
            PG8_LDA(At, 0, 1); PG8_STAGE(PG8_SA(0, 0), a2, voffA);
            PG8_BAR; PG8_WAIT_L(0); PG8_MMA(1, 0, At, B0); PG8_BAR; PG8_SCHED;
            PG8_STAGE(PG8_SB(0, 1), b2 + hstep, voffB);
            PG8_WAIT_V(6); PG8_BAR; PG8_MMA(1, 1, At, B1); PG8_BAR;
            PG8_LDB(B0, 1, 0); PG8_SCHED; PG8_LDA(At, 1, 0); PG8_STAGE(PG8_SA(0, 1), a2 + hstep, voffA);
            PG8_WAIT_L(8); PG8_BAR; PG8_WAIT_L(0); PG8_MMA(0, 0, At, B0); PG8_BAR; PG8_SCHED;
            PG8_LDB(B1, 1, 1); PG8_STAGE(PG8_SB(1, 0), b3, voffB);
            PG8_BAR; PG8_WAIT_L(0); PG8_MMA(0, 1, At, B1); PG8_BAR;
            PG8_LDA(At, 1, 1); PG8_STAGE(PG8_SA(1, 0), a3, voffA);
            PG8_BAR; PG8_WAIT_L(0); PG8_MMA(1, 0, At, B0); PG8_BAR; PG8_SCHED;
            PG8_STAGE(PG8_SB(1, 1), b3 + hstep, voffB);
            PG8_WAIT_V(6); PG8_BAR; PG8_MMA(1, 1, At, B1); PG8_BAR;
        }
        PG8_STAMP();
        bool keep_acc = false;
        if constexpr (!Epi::AFTER_DRAIN) {
            if constexpr (Epi::CHAIN) { keep_acc = E.first(cur); if (keep_acc) E.mid(acc, cur, wr, wc, fr, fq); else E(acc, cur, wr, wc, fr, fq); }
            else E(acc, cur, wr, wc, fr, fq);
            S.done(cur); }
        PG8_STAMP();
        if (!has_next) break;
        if (!keep_acc)
#pragma unroll
        for (int a = 0; a < 2; ++a)
#pragma unroll
            for (int b = 0; b < 2; ++b)
#pragma unroll
                for (int m = 0; m < 4; ++m)
#pragma unroll
                    for (int n = 0; n < 2; ++n) acc[a][b][m][n] = (f32x4){0.f, 0.f, 0.f, 0.f};
        cur = nxt; cA = nA; cB = nB; ++ui;
    }
    PG8_WAIT_V(0);
    if (wr == 0) PG8_BAR;
    PG8_BAR;
    if constexpr (Epi::AFTER_DRAIN) { E.fused(acc, cur, wr, wc, fr, fq, lds, wid, lane); S.done(cur); }
    PG8_STAMP();
    if (STAMP && wid == 0) { stamps[lane] = lane < nts ? (((unsigned long long)(unsigned)ts_hi << 32) | (unsigned)ts_lo) : 0ull;
        if (lane == 62) stamps[62] = rt_entry; if (lane == 63) stamps[63] = (unsigned long long)wall_clock64(); }
#undef PG8_STAMP
#undef PG8_SA
#undef PG8_SB
#undef PG8_STAGE
#undef PG8_LDA
#undef PG8_LDB
#undef PG8_MMA
#undef PG8_WAIT_V
#undef PG8_WAIT_L
#undef PG8_BAR
#undef PG8_SCHED
}
}

#define DI __device__ __forceinline__
#define LAS __attribute__((address_space(3)))
typedef unsigned short bf16_t;
typedef short bf16x8 __attribute__((ext_vector_type(8)));
typedef float f32x4 __attribute__((ext_vector_type(4)));
typedef float f32x16 __attribute__((ext_vector_type(16)));
typedef unsigned u32x4 __attribute__((ext_vector_type(4)));
typedef unsigned u32x2 __attribute__((ext_vector_type(2)));
typedef __bf16 bf2_t __attribute__((ext_vector_type(2)));
typedef float f2_t __attribute__((ext_vector_type(2)));
typedef unsigned long long u64;

constexpr int TH = 8192, SEQ = 4096, DM = 2048, NP = 17664, DFF = 5632;
constexpr int C_KV = 2048, C_GQ = 5120, C_Z = 11264, C_MA = 13312, C_MB = 15360, C_GATE = 17408, C_A = 17456, C_B = 17472;
constexpr float EPS = 1e-6f;
constexpr float QSCALE = 0.08838834764831845f * 1.4426950408889634f;

constexpr size_t WS_WAT = 0, WS_WBT = 8388608, WS_WOT = 16777216, WS_WCT = 25165824, WS_CMPC = 563359744, WS_CTR = 27264000,
                 WS_KC = 27267072, WS_VCT = 27791360, WS_SEL = 28315648, WS_GEXP = 28577792, WS_X = 28585984,
                 WS_H = WS_X, WS_WINT = 491008000, WS_GQG = WS_X, WS_GKGT = WS_X + 33554432, WS_GW = WS_X + 67108864,
                 WS_PROJ = 134492160, WS_GU = 423899136, WS_GQK = 457453568, WS_VT = 474230784,
                 WS_SSQ = 563367936, WS_RSTD = 565465088, WS_X1 = WS_X, WS_H2 = 162803712, WS_WGT = 229912576, WS_WDT = 276049920, WS_ACT = 299118592;
constexpr size_t DO_OA = 0, DO_OB = 33554432, DO_MIX = 67108864;

struct Params { const float* in[18]; float* out; unsigned char* ws; };

DI unsigned pk2(float a, float b) { f2_t v = {a, b}; return __builtin_bit_cast(unsigned, __builtin_convertvector(v, bf2_t)); }
DI float bflo(unsigned u) { return __uint_as_float(u << 16); }
DI float bfhi(unsigned u) { return __uint_as_float(u & 0xffff0000u); }
DI float bf2f(bf16_t h) { return __uint_as_float((unsigned)h << 16); }
DI bf16_t f2bf(float x) { return (bf16_t)(pk2(x, 0.f) & 0xffffu); }
template <int CTRL> DI float dppf(float v) { return __int_as_float(__builtin_amdgcn_update_dpp(0, __float_as_int(v), CTRL, 0xF, 0xF, true)); }
DI float sum8(float v) { v += dppf<0xB1>(v); v += dppf<0x4E>(v); v += dppf<0x141>(v); return v; }
DI float sum16(float v) { v = sum8(v); v += dppf<0x140>(v); return v; }
DI float wsum(float v) { v = sum16(v); v += __shfl_xor(v, 16); v += __shfl_xor(v, 32); return v; }
DI float sigm(float x) { return __builtin_amdgcn_rcpf(1.0f + __expf(-x)); }
DI float silu(float x) { return x * __builtin_amdgcn_rcpf(1.0f + __expf(-x)); }
DI f32x16 mfma32(bf16x8 a, bf16x8 b, f32x16 c) { return __builtin_amdgcn_mfma_f32_32x32x16_bf16(a, b, c, 0, 0, 0); }
DI f32x16 zero16() { f32x16 z; for (int i = 0; i < 16; ++i) z[i] = 0.f; return z; }
DI int crow(int reg, int h) { return (reg & 3) + 8 * (reg >> 2) + 4 * h; }
DI bf16x8 pack8(const f32x16& x, int s) { u32x4 p; p[0] = pk2(x[8 * s], x[8 * s + 1]); p[1] = pk2(x[8 * s + 2], x[8 * s + 3]); p[2] = pk2(x[8 * s + 4], x[8 * s + 5]); p[3] = pk2(x[8 * s + 6], x[8 * s + 7]); return __builtin_bit_cast(bf16x8, p); }
DI bf16x8 cat8(u32x2 a, u32x2 b) { u32x4 p = {a[0], a[1], b[0], b[1]}; return __builtin_bit_cast(bf16x8, p); }

template <int MAP> DI int map_row(int n) {
    if (MAP == 0) return n;
    if (MAP == 1) { if (n < 5120) return n; if (n < 5168) return 17408 + (n - 5120); if (n < 13360) return n - 48; if (n < 13376) return 17456 + (n - 13360); if (n < 13392) return 17472 + (n - 13376); return n - 80; }
    if (MAP == 2) return (n >> 7) * 256 + (n & 127);
    return (n >> 7) * 256 + 128 + (n & 127);
}
DI void xpose_ld(f32x4 (&v)[8], const float* src, int N, int kt, int nt, int tid) {
    const int k0 = kt * 64, n = nt * 256 + (tid & 63) * 4, r = tid >> 6;
#pragma unroll
    for (int i = 0; i < 8; ++i) { v[i] = (f32x4){0.f, 0.f, 0.f, 0.f}; if (n < N) v[i] = *(const f32x4*)(src + (size_t)(k0 + r + 8 * i) * N + n); }
}
template <int MAP> DI void xpose_put(LAS float* tile, const f32x4 (&v)[8], int K, int N, bf16_t* dst, int kt, int nt, int tid, const float* ksc) {
    const int k0 = kt * 64, n0 = nt * 256, r = tid >> 6, c4 = (tid & 63) * 4;
#pragma unroll
    for (int i = 0; i < 8; ++i) { LAS float* d = tile + (r + 8 * i) * 257 + c4; d[0] = v[i][0]; d[1] = v[i][1]; d[2] = v[i][2]; d[3] = v[i][3]; }
    __syncthreads();
    const int kc = tid & 7; float sc[8];
#pragma unroll
    for (int j = 0; j < 8; ++j) sc[j] = ksc ? ksc[k0 + kc * 8 + j] : 1.0f;
#pragma unroll
    for (int ps = 0; ps < 4; ++ps) { const int nl = ps * 64 + (tid >> 3), n = n0 + nl;
        if (n < N) { u32x4 w;
#pragma unroll
            for (int j = 0; j < 4; ++j) w[j] = pk2(tile[(kc * 8 + 2 * j) * 257 + nl] * sc[2 * j], tile[(kc * 8 + 2 * j + 1) * 257 + nl] * sc[2 * j + 1]);
            *(u32x4*)(dst + (size_t)map_row<MAP>(n) * K + k0 + kc * 8) = w; } }
    __syncthreads();
}
template <int MAP> DI void xpose_all(LAS float* tile, const float* src, int K, int N, bf16_t* dst, int tid, int bid, int G, const float* ksc = nullptr) {
    const int nkt = K / 64, nnt = (N + 255) / 256, tot = nkt * nnt;
    f32x4 va[8], vb[8];
    int i = bid;
    if (i < tot) xpose_ld(va, src, N, i / nnt, i % nnt, tid);
    for (; i < tot; i += 2 * G) {
        const int i1 = i + G, i2 = i + 2 * G;
        if (i1 < tot) xpose_ld(vb, src, N, i1 / nnt, i1 % nnt, tid);
        xpose_put<MAP>(tile, va, K, N, dst, i / nnt, i % nnt, tid, ksc);
        if (i1 < tot) {
            if (i2 < tot) xpose_ld(va, src, N, i2 / nnt, i2 % nnt, tid);
            xpose_put<MAP>(tile, vb, K, N, dst, i1 / nnt, i1 % nnt, tid, ksc);
        }
    }
}
DI void norm_rows(const float* x, const float* gain, bf16_t* out, int nrows, int tid, int bid, int G) {
    const int w = tid >> 6, lane = tid & 63;
    for (int row = bid * 8 + w; row < nrows; row += G * 8) {
        f32x4 v[8]; float ss = 0.f;
#pragma unroll
        for (int i = 0; i < 8; ++i) { v[i] = *(const f32x4*)(x + (size_t)row * DM + i * 256 + lane * 4); ss += v[i][0] * v[i][0] + v[i][1] * v[i][1] + v[i][2] * v[i][2] + v[i][3] * v[i][3]; }
        ss = wsum(ss); const float rs = rsqrtf(ss * (1.0f / DM) + EPS);
#pragma unroll
        for (int i = 0; i < 8; ++i) { const f32x4 gn = *(const f32x4*)(gain + i * 256 + lane * 4);
            u32x2 o; o[0] = pk2(v[i][0] * rs * gn[0], v[i][1] * rs * gn[1]); o[1] = pk2(v[i][2] * rs * gn[2], v[i][3] * rs * gn[3]);
            *(u32x2*)(out + (size_t)row * DM + i * 256 + lane * 4) = o; }
    }
}

struct EpiProj { static constexpr bool PERM = true, AFTER_DRAIN = false, CHAIN = false; bf16_t* O;
    DI void operator()(const pg8::f32x4 (&acc)[2][2][4][2], const pg8::Unit& u, int wr, int wc, int fr, int fq) const {
        const int row0 = u.pm * 256 + wr * 64 + fr, col0 = u.pn * 256 + wc * 32 + 8 * fq;
#pragma unroll
        for (int ai = 0; ai < 2; ++ai)
#pragma unroll
            for (int m = 0; m < 4; ++m) { bf16_t* rowp = O + (size_t)(row0 + ai * 128 + m * 16) * NP + col0;
#pragma unroll
                for (int bj = 0; bj < 2; ++bj) { const pg8::f32x4 v0 = acc[ai][bj][m][0], v1 = acc[ai][bj][m][1];
                    u32x4 w; w[0] = pk2(v0[0], v0[1]); w[1] = pk2(v0[2], v0[3]); w[2] = pk2(v1[0], v1[1]); w[3] = pk2(v1[2], v1[3]);
                    *(u32x4*)(rowp + bj * 128) = w; } }
    } };
template <bool ADD> struct EpiMix { static constexpr bool PERM = true, AFTER_DRAIN = false, CHAIN = false; bf16_t* MIX; const bf16_t* gate;
    DI void operator()(const pg8::f32x4 (&acc)[2][2][4][2], const pg8::Unit& u, int wr, int wc, int fr, int fq) const {
        const int row0 = u.pm * 256 + wr * 64 + fr, col0 = u.pn * 256 + wc * 32 + 8 * fq;
#pragma unroll
        for (int ai = 0; ai < 2; ++ai)
#pragma unroll
            for (int m = 0; m < 4; ++m) { const int row = row0 + ai * 128 + m * 16;
#pragma unroll
                for (int bj = 0; bj < 2; ++bj) { const pg8::f32x4 v0 = acc[ai][bj][m][0], v1 = acc[ai][bj][m][1];
                    const u32x4 gt = *(const u32x4*)(gate + (size_t)row * NP + col0 + bj * 128);
                    float o[8] = {v0[0], v0[1], v0[2], v0[3], v1[0], v1[1], v1[2], v1[3]};
#pragma unroll
                    for (int j = 0; j < 4; ++j) { o[2 * j] *= sigm(bflo(gt[j])); o[2 * j + 1] *= sigm(bfhi(gt[j])); }
                    bf16_t* dp = MIX + (size_t)row * DM + col0 + bj * 128;
                    if (ADD) { const u32x4 pr = *(const u32x4*)dp;
#pragma unroll
                        for (int j = 0; j < 4; ++j) { o[2 * j] += bflo(pr[j]); o[2 * j + 1] += bfhi(pr[j]); } }
                    u32x4 w; w[0] = pk2(o[0], o[1]); w[1] = pk2(o[2], o[3]); w[2] = pk2(o[4], o[5]); w[3] = pk2(o[6], o[7]);
                    *(u32x4*)dp = w; } }
    } };
struct EpiRes { static constexpr bool PERM = false, AFTER_DRAIN = false, CHAIN = false; float* C; const float* R;
    DI void operator()(const pg8::f32x4 (&acc)[2][2][4][2], const pg8::Unit& u, int wr, int wc, int fr, int fq) const {
        const int row0 = u.pm * 256 + wr * 64 + fr, col0 = u.pn * 256 + wc * 32 + 4 * fq;
#pragma unroll
        for (int ai = 0; ai < 2; ++ai)
#pragma unroll
            for (int m = 0; m < 4; ++m) { const size_t ro = (size_t)(row0 + ai * 128 + m * 16) * DM + col0;
#pragma unroll
                for (int bj = 0; bj < 2; ++bj)
#pragma unroll
                    for (int n = 0; n < 2; ++n) { const pg8::f32x4 rv = *(const pg8::f32x4*)(R + ro + bj * 128 + n * 16); *(pg8::f32x4*)(C + ro + bj * 128 + n * 16) = acc[ai][bj][m][n] + rv; } }
    } };
struct EpiResX { static constexpr bool PERM = false, AFTER_DRAIN = false, CHAIN = false; float* C; const float* R; bf16_t* Xb; float* SSQ;
    DI void operator()(const pg8::f32x4 (&acc)[2][2][4][2], const pg8::Unit& u, int wr, int wc, int fr, int fq) const {
        const int row0 = u.pm * 256 + wr * 64 + fr, col0 = u.pn * 256 + wc * 32 + 4 * fq;
#pragma unroll
        for (int ai = 0; ai < 2; ++ai)
#pragma unroll
            for (int m = 0; m < 4; ++m) { const int row = row0 + ai * 128 + m * 16; const size_t ro = (size_t)row * DM + col0; float ss = 0.f;
#pragma unroll
                for (int bj = 0; bj < 2; ++bj)
#pragma unroll
                    for (int n = 0; n < 2; ++n) { const pg8::f32x4 rv = *(const pg8::f32x4*)(R + ro + bj * 128 + n * 16); const pg8::f32x4 x = acc[ai][bj][m][n] + rv;
                        *(pg8::f32x4*)(C + ro + bj * 128 + n * 16) = x; *(u32x2*)(Xb + ro + bj * 128 + n * 16) = (u32x2){pk2(x[0], x[1]), pk2(x[2], x[3])};
                        ss += (x[0] * x[0] + x[1] * x[1]) + (x[2] * x[2] + x[3] * x[3]); }
                ss += __shfl_xor(ss, 16); ss += __shfl_xor(ss, 32);
                if (fq == 0) SSQ[(size_t)row * 32 + u.pn * 4 + wc] = ss; }
    } };
struct EpiGU2 { static constexpr bool PERM = true, AFTER_DRAIN = false, CHAIN = false; bf16_t* ACT; const float* RS;
    DI void operator()(const pg8::f32x4 (&acc)[2][2][4][2], const pg8::Unit& u, int wr, int wc, int fr, int fq) const {
        const int row0 = u.pm * 256 + wr * 64 + fr, col0 = u.pn * 128 + wc * 32 + 8 * fq;
#pragma unroll
        for (int ai = 0; ai < 2; ++ai)
#pragma unroll
            for (int m = 0; m < 4; ++m) { const int row = row0 + ai * 128 + m * 16; const float r = RS[row];
                const pg8::f32x4 g0 = acc[ai][0][m][0] * r, g1 = acc[ai][0][m][1] * r, u0 = acc[ai][1][m][0] * r, u1 = acc[ai][1][m][1] * r;
                u32x4 w; w[0] = pk2(silu(g0[0]) * u0[0], silu(g0[1]) * u0[1]); w[1] = pk2(silu(g0[2]) * u0[2], silu(g0[3]) * u0[3]);
                w[2] = pk2(silu(g1[0]) * u1[0], silu(g1[1]) * u1[1]); w[3] = pk2(silu(g1[2]) * u1[2], silu(g1[3]) * u1[3]);
                *(u32x4*)(ACT + (size_t)row * DFF + col0) = w; }
    } };
struct EpiGU { static constexpr bool PERM = true, AFTER_DRAIN = false, CHAIN = false; bf16_t* ACT;
    DI void operator()(const pg8::f32x4 (&acc)[2][2][4][2], const pg8::Unit& u, int wr, int wc, int fr, int fq) const {
        const int row0 = u.pm * 256 + wr * 64 + fr, col0 = u.pn * 128 + wc * 32 + 8 * fq;
#pragma unroll
        for (int ai = 0; ai < 2; ++ai)
#pragma unroll
            for (int m = 0; m < 4; ++m) { const pg8::f32x4 g0 = acc[ai][0][m][0], g1 = acc[ai][0][m][1], u0 = acc[ai][1][m][0], u1 = acc[ai][1][m][1];
                u32x4 w; w[0] = pk2(silu(g0[0]) * u0[0], silu(g0[1]) * u0[1]); w[1] = pk2(silu(g0[2]) * u0[2], silu(g0[3]) * u0[3]);
                w[2] = pk2(silu(g1[0]) * u1[0], silu(g1[1]) * u1[1]); w[3] = pk2(silu(g1[2]) * u1[2], silu(g1[3]) * u1[3]);
                *(u32x4*)(ACT + (size_t)(row0 + ai * 128 + m * 16) * DFF + col0) = w; }
    } };
struct BrOrder : pg8::StaticOrder {
    __device__ bool next(int i, pg8::Unit& u) const { if (!pg8::StaticOrder::next(i >> 1, u)) return false; if (i & 1) { u.pm += 32; u.pn += 8; } return true; }
};
struct EpiMix2 { static constexpr bool PERM = true, AFTER_DRAIN = false, CHAIN = true; bf16_t* MIX; const bf16_t* P;
    DI bool first(const pg8::Unit& u) const { return u.pm < 32; }
    DI void mid(pg8::f32x4 (&acc)[2][2][4][2], const pg8::Unit& u, int wr, int wc, int fr, int fq) const {
        const int row0 = u.pm * 256 + wr * 64 + fr, col0 = u.pn * 256 + wc * 32 + 8 * fq;
#pragma unroll
        for (int ai = 0; ai < 2; ++ai)
#pragma unroll
            for (int m = 0; m < 4; ++m) { const size_t ro = (size_t)(row0 + ai * 128 + m * 16) * NP + col0;
#pragma unroll
                for (int bj = 0; bj < 2; ++bj) { const u32x4 ga = *(const u32x4*)(P + ro + C_MA + bj * 128), gb = *(const u32x4*)(P + ro + C_MB + bj * 128);
#pragma unroll
                    for (int j = 0; j < 4; ++j) { const float r0 = (1.0f + __expf(-bflo(gb[j]))) * __builtin_amdgcn_rcpf(1.0f + __expf(-bflo(ga[j]))), r1 = (1.0f + __expf(-bfhi(gb[j]))) * __builtin_amdgcn_rcpf(1.0f + __expf(-bfhi(ga[j])));
                        acc[ai][bj][m][j >> 1][(j & 1) * 2] *= r0; acc[ai][bj][m][j >> 1][(j & 1) * 2 + 1] *= r1; } } }
    }
    DI void operator()(const pg8::f32x4 (&acc)[2][2][4][2], const pg8::Unit& u, int wr, int wc, int fr, int fq) const {
        const int row0 = (u.pm - 32) * 256 + wr * 64 + fr, col0 = (u.pn - 8) * 256 + wc * 32 + 8 * fq;
#pragma unroll
        for (int ai = 0; ai < 2; ++ai)
#pragma unroll
            for (int m = 0; m < 4; ++m) { const int row = row0 + ai * 128 + m * 16;
#pragma unroll
                for (int bj = 0; bj < 2; ++bj) { const pg8::f32x4 v0 = acc[ai][bj][m][0], v1 = acc[ai][bj][m][1];
                    const u32x4 gb = *(const u32x4*)(P + (size_t)row * NP + C_MB + col0 + bj * 128);
                    u32x4 w; w[0] = pk2(v0[0] * sigm(bflo(gb[0])), v0[1] * sigm(bfhi(gb[0]))); w[1] = pk2(v0[2] * sigm(bflo(gb[1])), v0[3] * sigm(bfhi(gb[1])));
                    w[2] = pk2(v1[0] * sigm(bflo(gb[2])), v1[1] * sigm(bfhi(gb[2]))); w[3] = pk2(v1[2] * sigm(bflo(gb[3])), v1[3] * sigm(bfhi(gb[3])));
                    *(u32x4*)(MIX + (size_t)row * DM + col0 + bj * 128) = w; } }
    } };
struct HalfOrder : pg8::StaticOrder {
    int n0;
    __device__ void init2(int M, int N, int G_, int c_) { pg8::StaticOrder::init(M / 2, N, G_, c_); n0 = c_ < nwg ? (nwg - c_ + G_ - 1) / G_ : 0; }
    __device__ bool next(int i, pg8::Unit& u) const { if (i >= 2 * n0) return false; const int h = i >= n0 ? 1 : 0; pg8::StaticOrder::next(i - h * n0, u); u.pm += h * nM; return true; }
};
template <class Epi> DI void run_gemm_half(LAS unsigned char* lds, const bf16_t* A, const bf16_t* Bt, int M, int N, int K, const Epi& E) {
    pg8::Gemm g{A, Bt, M, N, K}; HalfOrder S; S.init2(M, N, (int)gridDim.x, (int)blockIdx.x);
    pg8::gemm_phase<Epi, HalfOrder, false>((PG8_LAS unsigned char*)lds, g, S, E, nullptr);
    __syncthreads();
}
template <class Epi> DI void run_gemm(LAS unsigned char* lds, const bf16_t* A, const bf16_t* Bt, int M, int N, int K, const Epi& E) {
    pg8::Gemm g{A, Bt, M, N, K}; pg8::StaticOrder S; S.init(M, N, (int)gridDim.x, (int)blockIdx.x);
    pg8::gemm_phase<Epi, pg8::StaticOrder, false>((PG8_LAS unsigned char*)lds, g, S, E, nullptr);
    __syncthreads();
}

DI void qk_norm_item(bf16_t* PROJ, const float* qg, const float* kg, int item, int tid) {
    asm volatile("" : "+v"(tid));
    const int w = tid >> 6, lane = tid & 63, sub = lane & 15, vq = lane >> 4;
#pragma unroll 1
    for (int tt = 0; tt < 2; ++tt) {
        const int tok = item * 16 + w * 2 + tt;
#pragma unroll 1
        for (int it = 0; it < 6; ++it) {
            const int vi = it * 4 + vq;
            int col; const float* gn; float sc = 1.0f;
            if (vi < 16) { col = vi * 128; gn = qg; sc = QSCALE; }
            else if (vi < 20) { col = C_KV + (8 + (vi - 16)) * 128; gn = kg + 128; }
            else { col = C_KV + (16 + (vi - 20)) * 128; gn = kg + 256; }
            bf16_t* p = PROJ + (size_t)tok * NP + col + sub * 8;
            const u32x4 raw = *(const u32x4*)p; float v[8];
#pragma unroll
            for (int j = 0; j < 4; ++j) { v[2 * j] = bflo(raw[j]); v[2 * j + 1] = bfhi(raw[j]); }
            float ss = 0.f;
#pragma unroll
            for (int j = 0; j < 8; ++j) ss += v[j] * v[j];
            ss = sum16(ss);
            const float rs = rsqrtf(ss * (1.0f / 128.0f) + EPS) * sc;
            const f32x4 g0 = *(const f32x4*)(gn + sub * 8), g1 = *(const f32x4*)(gn + sub * 8 + 4);
            u32x4 o; o[0] = pk2(v[0] * rs * g0[0], v[1] * rs * g0[1]); o[1] = pk2(v[2] * rs * g0[2], v[3] * rs * g0[3]);
            o[2] = pk2(v[4] * rs * g1[0], v[5] * rs * g1[1]); o[3] = pk2(v[6] * rs * g1[2], v[7] * rs * g1[3]);
            *(u32x4*)p = o;
        }
    }
}
DI void cmp_item(LAS unsigned char* L, const bf16_t* PROJ, const bf16_t* WCT, const float* cmpc, const float* kgain, bf16_t* KC, bf16_t* VCT, int item, int tid) {
    asm volatile("" : "+v"(tid));
    const int rq = item & 3, kv = (item >> 2) & 1, g = (item >> 3) & 3, bl = item >> 5;
    const int w = tid >> 6, lane = tid & 63, c = lane & 31, hf = lane >> 5, mt = w & 1, et = w >> 1;
    int n = rq * 64 + mt * 32 + c; if (n > 254) n = 254;
    const bf16_t* ap = PROJ + (size_t)(bl * SEQ + 16 * n) * NP + C_KV + (kv * 4 + g) * 128 + hf * 8;
    const bf16_t* bp = WCT + (size_t)kv * 128 * 4096 + (size_t)(et * 32 + c) * 4096 + hf * 8;
    f32x16 acc = zero16();
#pragma unroll 1
    for (int l = 0; l < 32; ++l) {
#pragma unroll
        for (int ds = 0; ds < 8; ++ds) {
            const bf16x8 a = *(const bf16x8*)(ap + (size_t)l * NP + ds * 16);
            const bf16x8 b = *(const bf16x8*)(bp + l * 128 + ds * 16);
            acc = mfma32(a, b, acc);
        }
    }
    LAS float* st = (LAS float*)L;
    const int e = et * 32 + c; float cc = 0.f;
#pragma unroll
    for (int i = 0; i < 8; ++i) cc += cmpc[(kv * 8 + i) * 128 + e];
#pragma unroll
    for (int i = 0; i < 16; ++i) st[(mt * 32 + crow(i, hf)) * 129 + e] = acc[i] + cc;
    __syncthreads();
    if (kv == 0) {
#pragma unroll 1
        for (int rr = 0; rr < 8; ++rr) { const int row = w * 8 + rr, nn = rq * 64 + row;
            const float v0 = st[row * 129 + lane], v1 = st[row * 129 + lane + 64];
            const float ss = wsum(v0 * v0 + v1 * v1), rs = rsqrtf(ss * (1.0f / 128.0f) + EPS);
            bf16_t* d = KC + ((size_t)(bl * 256 + nn) * 4 + g) * 128;
            d[lane] = f2bf(v0 * rs * kgain[lane]); d[lane + 64] = f2bf(v1 * rs * kgain[lane + 64]); }
    } else {
        const int ee = tid >> 2, nc = (tid & 3) * 16; u32x4 o[2];
#pragma unroll
        for (int j = 0; j < 8; ++j) { const int r0 = nc + 2 * j; float a = st[r0 * 129 + ee], b = st[(r0 + 1) * 129 + ee];
            if (rq * 64 + r0 >= 255) a = 0.f; if (rq * 64 + r0 + 1 >= 255) b = 0.f; o[j >> 2][j & 3] = pk2(a, b); }
        bf16_t* d = VCT + ((size_t)(bl * 4 + g) * 128 + ee) * 256 + rq * 64 + nc;
        *(u32x4*)d = o[0]; *(u32x4*)(d + 8) = o[1];
    }
    __syncthreads();
}
DI void vt_item(LAS unsigned char* L, const bf16_t* PROJ, bf16_t* VT, int item, int tid) {
    asm volatile("" : "+v"(tid));
    const int tb = item & 63, g = (item >> 6) & 3, bl = (item >> 8) & 1, br = item >> 9;
    const bf16_t* src = PROJ + (size_t)(bl * SEQ + tb * 64) * NP + C_KV + (((br + 1) * 2 + 1) * 4 + g) * 128;
#pragma unroll
    for (int i = 0; i < 2; ++i) { const int c = tid + 512 * i, tok = c >> 4, part = c & 15;
        const u32x4 v = *(const u32x4*)(src + (size_t)tok * NP + part * 8);
        LAS u32x2* d = (LAS u32x2*)(L + tok * 264 + part * 16); d[0] = (u32x2){v[0], v[1]}; d[1] = (u32x2){v[2], v[3]}; }
    __syncthreads();
    const int d = tid >> 2, tc = (tid & 3) * 16; u32x4 o[2];
#pragma unroll
    for (int j = 0; j < 8; ++j) { const unsigned a = *(LAS bf16_t*)(L + (tc + 2 * j) * 264 + d * 2), b = *(LAS bf16_t*)(L + (tc + 2 * j + 1) * 264 + d * 2); o[j >> 2][j & 3] = a | (b << 16); }
    bf16_t* dst = VT + ((size_t)((br * 2 + bl) * 4 + g) * 128 + d) * SEQ + tb * 64 + tc;
    *(u32x4*)dst = o[0]; *(u32x4*)(dst + 8) = o[1];
    __syncthreads();
}
constexpr int GP_QB = 0, GP_KB = 17408, GP_KGT = 34816, GP_KBGT = 53248, GP_VBT = 71680, GP_LM = 90112, GP_TB = 107520, GP_QKS = 116736, GP_GC = 125952, GP_BETA = 126208;
DI void ld_lrows(unsigned addr, f32x4 (&lo)[8], f32x4 (&hi)[8]) {
    asm volatile("ds_read_b128 %0, %16\n\tds_read_b128 %8, %16 offset:16\n\tds_read_b128 %1, %16 offset:272\n\tds_read_b128 %9, %16 offset:288\n\t"
                 "ds_read_b128 %2, %16 offset:544\n\tds_read_b128 %10, %16 offset:560\n\tds_read_b128 %3, %16 offset:816\n\tds_read_b128 %11, %16 offset:832\n\t"
                 "ds_read_b128 %4, %16 offset:1088\n\tds_read_b128 %12, %16 offset:1104\n\tds_read_b128 %5, %16 offset:1360\n\tds_read_b128 %13, %16 offset:1376\n\t"
                 "ds_read_b128 %6, %16 offset:1632\n\tds_read_b128 %14, %16 offset:1648\n\tds_read_b128 %7, %16 offset:1904\n\tds_read_b128 %15, %16 offset:1920\n\t"
                 "s_waitcnt lgkmcnt(0)"
                 : "=&v"(lo[0]), "=&v"(lo[1]), "=&v"(lo[2]), "=&v"(lo[3]), "=&v"(lo[4]), "=&v"(lo[5]), "=&v"(lo[6]), "=&v"(lo[7]),
                   "=&v"(hi[0]), "=&v"(hi[1]), "=&v"(hi[2]), "=&v"(hi[3]), "=&v"(hi[4]), "=&v"(hi[5]), "=&v"(hi[6]), "=&v"(hi[7])
                 : "v"(addr) : "memory");
}
DI void gdn_prep_item(LAS unsigned char* L, const bf16_t* PROJ, const float* convw, const float* a_log, const float* dt_bias,
                      bf16_t* GQG, bf16_t* GKGT, bf16_t* GW, bf16_t* GUT, bf16_t* GQK, float* GEXP, int unit, int tid) {
    asm volatile("" : "+v"(tid));
    const int h = unit & 15, n = (unit >> 4) & 63, bl = unit >> 10;
    const int w = tid >> 6, lane = tid & 63, c = lane & 31, hf = lane >> 5;
    LAS float* gcs = (LAS float*)(L + GP_GC); LAS float* betas = (LAS float*)(L + GP_BETA);
    const bf16_t* base = PROJ + (size_t)(bl * SEQ) * NP;
    const int sl0 = n * 64 + w * 8;
    unsigned raw[3][11]; float cw[3][4][2];
#pragma unroll
        for (int wh = 0; wh < 3; ++wh) { const int col = C_GQ + wh * 2048 + h * 128 + 2 * lane;
#pragma unroll
            for (int r = 0; r < 11; ++r) { const int sl = sl0 - 3 + r; raw[wh][r] = (sl >= 0) ? *(const unsigned*)(base + (size_t)sl * NP + col) : 0u; }
#pragma unroll
            for (int i = 0; i < 4; ++i) { const f2_t cv = *(const f2_t*)(convw + (size_t)i * 6144 + wh * 2048 + h * 128 + 2 * lane); cw[wh][i][0] = cv[0]; cw[wh][i][1] = cv[1]; } }
    if (w == 0) {
        const size_t tok = (size_t)(n * 64 + lane);
        const float av = bf2f(base[tok * NP + C_A + h]), bv = bf2f(base[tok * NP + C_B + h]);
        const float xs = av + dt_bias[h]; const float sp = xs > 15.f ? xs : __logf(1.0f + __expf(xs));
        float gv = -__expf(a_log[h]) * sp;
#pragma unroll
        for (int o = 1; o < 64; o <<= 1) { const float t = __shfl_up(gv, o); if (lane >= o) gv += t; }
        gcs[lane] = gv; betas[lane] = sigm(bv);
    }
    __syncthreads();
    const float glast = gcs[63];
    {
        float pkg[2], pkbg[2], pvb[2];
#pragma unroll
        for (int tt = 0; tt < 8; ++tt) {
            float y[3][2];
#pragma unroll
            for (int wh = 0; wh < 3; ++wh) { float a0 = 0.f, a1 = 0.f;
#pragma unroll
                for (int i = 0; i < 4; ++i) { a0 += cw[wh][i][0] * bflo(raw[wh][tt + i]); a1 += cw[wh][i][1] * bfhi(raw[wh][tt + i]); }
                y[wh][0] = silu(a0); y[wh][1] = silu(a1); }
            const float ssq = wsum(y[0][0] * y[0][0] + y[0][1] * y[0][1]), ssk = wsum(y[1][0] * y[1][0] + y[1][1] * y[1][1]);
            const float qs = rsqrtf(ssq + EPS) * 0.08838834764831845f, ks = rsqrtf(ssk + EPS);
            const int t = w * 8 + tt; const float gct = gcs[t], bt = betas[t], eg = __expf(gct), ek = __expf(glast - gct);
            const float q0 = y[0][0] * qs, q1 = y[0][1] * qs, k0 = y[1][0] * ks, k1 = y[1][1] * ks;
            *(LAS unsigned*)(L + GP_QB + (t * 136 + 2 * lane) * 2) = pk2(q0, q1);
            *(LAS unsigned*)(L + GP_KB + (t * 136 + 2 * lane) * 2) = pk2(k0, k1);
            *(unsigned*)(GQG + (size_t)unit * 8192 + t * 128 + 2 * lane) = pk2(q0 * eg, q1 * eg);
            const float kg0 = k0 * ek, kg1 = k1 * ek, kb0 = k0 * bt * eg, kb1 = k1 * bt * eg, vb0 = y[2][0] * bt, vb1 = y[2][1] * bt;
            if (tt & 1) {
                *(LAS unsigned*)(L + GP_KGT + ((2 * lane) * 72 + t - 1) * 2) = pk2(pkg[0], kg0); *(LAS unsigned*)(L + GP_KGT + ((2 * lane + 1) * 72 + t - 1) * 2) = pk2(pkg[1], kg1);
                *(LAS unsigned*)(L + GP_KBGT + ((2 * lane) * 72 + t - 1) * 2) = pk2(pkbg[0], kb0); *(LAS unsigned*)(L + GP_KBGT + ((2 * lane + 1) * 72 + t - 1) * 2) = pk2(pkbg[1], kb1);
                *(LAS unsigned*)(L + GP_VBT + ((2 * lane) * 72 + t - 1) * 2) = pk2(pvb[0], vb0); *(LAS unsigned*)(L + GP_VBT + ((2 * lane + 1) * 72 + t - 1) * 2) = pk2(pvb[1], vb1);
            } else { pkg[0] = kg0; pkg[1] = kg1; pkbg[0] = kb0; pkbg[1] = kb1; pvb[0] = vb0; pvb[1] = vb1; }
        }
    }
    __syncthreads();
    {
        const int which = w >> 2, ti = (w >> 1) & 1, tj = w & 1;
        f32x16 acc = zero16();
        if (ti >= tj) {
#pragma unroll
            for (int s = 0; s < 8; ++s) {
                const bf16x8 a = *(const LAS bf16x8*)(L + (which ? GP_QB : GP_KB) + ((ti * 32 + c) * 136 + 16 * s + 8 * hf) * 2);
                const bf16x8 b = *(const LAS bf16x8*)(L + GP_KB + ((tj * 32 + c) * 136 + 16 * s + 8 * hf) * 2);
                acc = mfma32(a, b, acc);
            }
        }
        const int j = tj * 32 + c; const float gj = gcs[j];
#pragma unroll
        for (int r = 0; r < 16; ++r) { const int i = ti * 32 + crow(r, hf); const float gi = gcs[i];
            if (which == 0) { const float v = (i > j) ? betas[i] * acc[r] * __expf(gi - gj) : 0.f; *(LAS float*)(L + GP_LM + (i * 68 + (j & 7) * 8 + (j >> 3)) * 4) = v; }
            else { const float v = (i >= j) ? acc[r] * __expf(gi - gj) : 0.f; *(LAS bf16_t*)(L + GP_QKS + (i * 72 + j) * 2) = f2bf(v); } }
    }
    __syncthreads();
    {
        const int mp = lane & 7, j = 8 * w + (lane >> 3); float xr[8];
#pragma unroll
        for (int k = 0; k < 8; ++k) xr[k] = 0.f;
#pragma unroll
        for (int i8 = 0; i8 < 8; ++i8) {
            f32x4 lo[8], hi[8];
            ld_lrows((unsigned)(unsigned long)(L + GP_LM + ((8 * i8) * 68 + mp * 8) * 4), lo, hi);
#pragma unroll
            for (int r = 0; r < 8; ++r) { const int i = 8 * i8 + r; float a = 0.f;
#pragma unroll
                for (int k = 0; k < 8; ++k) if (8 * k < i) a += (k < 4 ? lo[r][k & 3] : hi[r][k & 3]) * xr[k];
                a = sum8(a);
                const float x = ((i == j) ? 1.f : 0.f) - a;
                if (mp == r) xr[i8] = x; }
        }
#pragma unroll
        for (int k = 0; k < 8; ++k) *(LAS bf16_t*)(L + GP_TB + ((8 * k + mp) * 72 + j) * 2) = f2bf(xr[k]);
    }
    __syncthreads();
    {
        const int mt = w & 1, dt = w >> 1; f32x16 au = zero16(), aw = zero16();
#pragma unroll
        for (int s = 0; s < 4; ++s) {
            const bf16x8 tb = *(const LAS bf16x8*)(L + GP_TB + ((mt * 32 + c) * 72 + 16 * s + 8 * hf) * 2);
            const bf16x8 vb = *(const LAS bf16x8*)(L + GP_VBT + ((dt * 32 + c) * 72 + 16 * s + 8 * hf) * 2);
            const bf16x8 kb = *(const LAS bf16x8*)(L + GP_KBGT + ((dt * 32 + c) * 72 + 16 * s + 8 * hf) * 2);
            au = mfma32(tb, vb, au); aw = mfma32(kb, tb, aw);
        }
#pragma unroll
        for (int q = 0; q < 4; ++q) {
            *(u32x2*)(GUT + (size_t)unit * 8192 + (dt * 32 + c) * 64 + mt * 32 + 8 * q + 4 * hf) = (u32x2){pk2(au[4 * q], au[4 * q + 1]), pk2(au[4 * q + 2], au[4 * q + 3])};
            *(u32x2*)(GW + (size_t)unit * 8192 + (mt * 32 + c) * 128 + dt * 32 + 8 * q + 4 * hf) = (u32x2){pk2(aw[4 * q], aw[4 * q + 1]), pk2(aw[4 * q + 2], aw[4 * q + 3])};
        }
#pragma unroll
        for (int i = 0; i < 2; ++i) { const int cc = tid + 512 * i, d = cc >> 3, part = cc & 7;
            *(u32x4*)(GKGT + (size_t)unit * 8192 + d * 64 + part * 8) = *(const LAS u32x4*)(L + GP_KGT + (d * 72 + part * 8) * 2); }
        { const int r = tid >> 3, part = tid & 7; *(u32x4*)(GQK + (size_t)unit * 4096 + r * 64 + part * 8) = *(const LAS u32x4*)(L + GP_QKS + (r * 72 + part * 8) * 2); }
        if (tid == 0) GEXP[unit] = __expf(glast);
    }
    __syncthreads();
}

DI void cmp_attn_item(LAS unsigned char* L, const bf16_t* PROJ, const bf16_t* KC, const bf16_t* VCT, bf16_t* OA, unsigned* SEL, const float* moff, int item, int tid) {
    asm volatile("" : "+v"(tid));
    const int qb = (item & 256) ? (item & 63) : 63 - (item & 63), g = (item >> 6) & 3, bl = (item >> 8) & 1 ? 1 : 0;
    const int w = tid >> 6, lane = tid & 63, c = lane & 31, hf = lane >> 5;
    const int tl = w * 8 + (c >> 2), r = c & 3, t = qb * 64 + tl, tok = bl * SEQ + t, h = g * 4 + r;
    bf16x8 qf[8];
#pragma unroll
    for (int s = 0; s < 8; ++s) qf[s] = *(const bf16x8*)(PROJ + (size_t)tok * NP + h * 128 + 16 * s + 8 * hf);
    const int ntile = (4 * qb + 34) >> 5, nvalid = t >= 31 ? ((t - 31) >> 4) + 1 : 0, lim = nvalid - 4 * hf;
    const bf16_t* kcb = KC + ((size_t)(bl * 256 + c) * 4 + g) * 128 + 8 * hf;
    const bf16_t* vcb = VCT + ((size_t)(bl * 4 + g) * 128 + c) * 256 + 4 * hf;
    const float m = moff[0];
    LAS float* Lv = (LAS float*)L + tid; float lsum = 0.f, Elast = 0.f; f32x16 O[4];
#pragma unroll
    for (int d = 0; d < 4; ++d) O[d] = zero16();
#pragma unroll
    for (int tau = 0; tau < 8; ++tau) {
        if (tau < ntile) {
            f32x16 acc = zero16();
#pragma unroll
            for (int s = 0; s < 8; ++s) acc = mfma32(*(const bf16x8*)(kcb + (size_t)tau * 32 * 512 + 16 * s), qf[s], acc);
#pragma unroll
            for (int i = 0; i < 16; ++i) { const float p = (32 * tau + crow(i, 0) < lim) ? __builtin_amdgcn_exp2f(acc[i] - m) : 0.f; acc[i] = p; lsum += p; }
#pragma unroll
            for (int a = 0; a < 4; ++a) { const float Wq = acc[4 * a] + acc[4 * a + 1] + acc[4 * a + 2] + 0.5f * acc[4 * a + 3], Eq = 0.5f * acc[4 * a + 3];
                const float ep_same = __shfl_xor(Eq, 32), ep_prev = __shfl_xor(Elast, 32);
                Lv[(tau * 4 + a) * 512] = Wq + (hf ? ep_same : ep_prev); Elast = Eq; }
#pragma unroll
            for (int s2 = 0; s2 < 2; ++s2) { const bf16x8 pf = pack8(acc, s2);
#pragma unroll
                for (int d = 0; d < 4; ++d) { const bf16_t* vp = vcb + (size_t)d * 32 * 256 + 32 * tau + 16 * s2;
                    O[d] = mfma32(cat8(*(const u32x2*)vp, *(const u32x2*)(vp + 8)), pf, O[d]); } }
        } else {
#pragma unroll
            for (int a = 0; a < 4; ++a) Lv[(tau * 4 + a) * 512] = 0.f;
        }
    }
    lsum += __shfl_xor(lsum, 32);
    const float inv = lsum > 0.f ? 1.0f / lsum : 0.f;
    {
        const float g0 = sigm(bf2f(PROJ[(size_t)tok * NP + C_GATE + h * 3 + 0])) * inv;
#pragma unroll
        for (int d = 0; d < 4; ++d)
#pragma unroll
            for (int q = 0; q < 4; ++q) *(u32x2*)(OA + (size_t)tok * DM + h * 128 + d * 32 + 8 * q + 4 * hf) = (u32x2){pk2(O[d][4 * q] * g0, O[d][4 * q + 1] * g0), pk2(O[d][4 * q + 2] * g0, O[d][4 * q + 3] * g0)};
    }
    LAS float* SC = (LAS float*)(L + 65536) + w * 520;
#pragma unroll
    for (int q = 0; q < 32; ++q) {
        float v = Lv[q * 512] * inv; v += dppf<0xB1>(v); v += dppf<0x4E>(v);
        const int j = 2 * q + hf; const bool forced = (j == 0) | (j == qb) | (j == qb - 1), causal = j <= qb;
        if (r == 0) SC[(c >> 2) * 65 + j] = forced ? 1e4f : (causal ? v : -1e4f);
    }
    asm volatile("s_waitcnt lgkmcnt(0)" ::: "memory");
    {
        const int tk = lane >> 3, jb = (lane & 7) * 8; float sv[8]; int cnt[8];
#pragma unroll
        for (int e = 0; e < 8; ++e) { sv[e] = SC[tk * 65 + jb + e]; cnt[e] = 0; }
#pragma unroll 4
        for (int j2 = 0; j2 < 64; ++j2) { const float v = SC[tk * 65 + j2];
#pragma unroll
            for (int e = 0; e < 8; ++e) cnt[e] += ((v > sv[e]) || (v == sv[e] && j2 < jb + e)) ? 1 : 0; }
        unsigned bits = 0u;
#pragma unroll
        for (int e = 0; e < 8; ++e) bits |= (cnt[e] < 16 && jb + e <= qb) ? (1u << e) : 0u;
        unsigned lo = (lane & 4) ? 0u : (bits << (jb & 31)), hi = (lane & 4) ? (bits << (jb & 31)) : 0u;
        lo |= __shfl_xor(lo, 1); hi |= __shfl_xor(hi, 1); lo |= __shfl_xor(lo, 2); hi |= __shfl_xor(hi, 2); lo |= __shfl_xor(lo, 4); hi |= __shfl_xor(hi, 4);
        if ((lane & 7) == 0) *(u32x2*)(SEL + ((size_t)(bl * SEQ + qb * 64 + w * 8 + tk) * 4 + g) * 2) = (u32x2){lo, hi};
    }
    asm volatile("s_waitcnt lgkmcnt(0)" ::: "memory");
}

constexpr int AT_K = 0, AT_V = 34816, AT_MISC = 71680;
DI void at_load(const bf16_t* Kg, const bf16_t* VTg, int j, int tid, u32x4 (&kr)[2], u32x4 (&vr)[2]) {
    const char* kb = (const char*)(Kg + (size_t)j * 64 * NP); const char* vb = (const char*)(VTg + j * 64);
#pragma unroll
    for (int i = 0; i < 2; ++i) { const int cc = tid + 512 * i; unsigned ko = (unsigned)(((cc >> 4) * NP + (cc & 15) * 8) * 2), vo = (unsigned)(((cc >> 3) * SEQ + (cc & 7) * 8) * 2);
        asm volatile("" : "+v"(ko), "+v"(vo));
        kr[i] = *(const u32x4*)(kb + ko); vr[i] = *(const u32x4*)(vb + vo); }
}
DI void at_store(LAS unsigned char* L, int buf, int tid, const u32x4 (&kr)[2], const u32x4 (&vr)[2]) {
#pragma unroll
    for (int i = 0; i < 2; ++i) { const int cc = tid + 512 * i, part = cc & 7;
        *(LAS u32x4*)(L + AT_K + buf * 17408 + (cc >> 4) * 272 + (cc & 15) * 16) = kr[i];
        LAS unsigned char* d = L + AT_V + buf * 18432 + (cc >> 3) * 144 + (part >> 1) * 32 + (part & 1) * 8;
        *(LAS u32x2*)d = (u32x2){vr[i][0], vr[i][1]}; *(LAS u32x2*)(d + 16) = (u32x2){vr[i][2], vr[i][3]}; }
}
DI int at_next(int j, int qb, u64 um) { for (++j; j <= qb; ++j) if ((um >> j) & 1ull) break; return j; }
DI void qk_chain(f32x16& sc, unsigned addr, const bf16x8 (&q)[8]) {
    bf16x8 k0, k1, k2, k3, k4, k5, k6, k7;
    asm volatile(
        "ds_read_b128 %1, %9\n\tds_read_b128 %2, %9 offset:32\n\tds_read_b128 %3, %9 offset:64\n\tds_read_b128 %4, %9 offset:96\n\t"
        "ds_read_b128 %5, %9 offset:128\n\tds_read_b128 %6, %9 offset:160\n\tds_read_b128 %7, %9 offset:192\n\tds_read_b128 %8, %9 offset:224\n\t"
        "s_waitcnt lgkmcnt(7)\n\tv_mfma_f32_32x32x16_bf16 %0, %1, %10, %0\n\t"
        "s_waitcnt lgkmcnt(6)\n\tv_mfma_f32_32x32x16_bf16 %0, %2, %11, %0\n\t"
        "s_waitcnt lgkmcnt(5)\n\tv_mfma_f32_32x32x16_bf16 %0, %3, %12, %0\n\t"
        "s_waitcnt lgkmcnt(4)\n\tv_mfma_f32_32x32x16_bf16 %0, %4, %13, %0\n\t"
        "s_waitcnt lgkmcnt(3)\n\tv_mfma_f32_32x32x16_bf16 %0, %5, %14, %0\n\t"
        "s_waitcnt lgkmcnt(2)\n\tv_mfma_f32_32x32x16_bf16 %0, %6, %15, %0\n\t"
        "s_waitcnt lgkmcnt(1)\n\tv_mfma_f32_32x32x16_bf16 %0, %7, %16, %0\n\t"
        "s_waitcnt lgkmcnt(0)\n\tv_mfma_f32_32x32x16_bf16 %0, %8, %17, %0\n\t"
        "s_nop 15\n\ts_nop 3"
        : "+v"(sc), "=&v"(k0), "=&v"(k1), "=&v"(k2), "=&v"(k3), "=&v"(k4), "=&v"(k5), "=&v"(k6), "=&v"(k7)
        : "v"(addr), "v"(q[0]), "v"(q[1]), "v"(q[2]), "v"(q[3]), "v"(q[4]), "v"(q[5]), "v"(q[6]), "v"(q[7])
        : "memory");
}
DI void pv_chain(f32x16& o0, f32x16& o1, f32x16& o2, f32x16& o3, unsigned addr, bf16x8 p0, bf16x8 p1) {
    bf16x8 v0, v1, v2, v3, v4, v5, v6, v7;
    asm volatile(
        "ds_read_b128 %4, %12\n\tds_read_b128 %5, %12 offset:4608\n\tds_read_b128 %6, %12 offset:9216\n\tds_read_b128 %7, %12 offset:13824\n\t"
        "ds_read_b128 %8, %12 offset:32\n\tds_read_b128 %9, %12 offset:4640\n\tds_read_b128 %10, %12 offset:9248\n\tds_read_b128 %11, %12 offset:13856\n\t"
        "s_waitcnt lgkmcnt(7)\n\tv_mfma_f32_32x32x16_bf16 %0, %4, %13, %0\n\t"
        "s_waitcnt lgkmcnt(6)\n\tv_mfma_f32_32x32x16_bf16 %1, %5, %13, %1\n\t"
        "s_waitcnt lgkmcnt(5)\n\tv_mfma_f32_32x32x16_bf16 %2, %6, %13, %2\n\t"
        "s_waitcnt lgkmcnt(4)\n\tv_mfma_f32_32x32x16_bf16 %3, %7, %13, %3\n\t"
        "s_waitcnt lgkmcnt(3)\n\tv_mfma_f32_32x32x16_bf16 %0, %8, %14, %0\n\t"
        "s_waitcnt lgkmcnt(2)\n\tv_mfma_f32_32x32x16_bf16 %1, %9, %14, %1\n\t"
        "s_waitcnt lgkmcnt(1)\n\tv_mfma_f32_32x32x16_bf16 %2, %10, %14, %2\n\t"
        "s_waitcnt lgkmcnt(0)\n\tv_mfma_f32_32x32x16_bf16 %3, %11, %14, %3\n\t"
        "s_nop 15\n\ts_nop 3"
        : "+v"(o0), "+v"(o1), "+v"(o2), "+v"(o3), "=&v"(v0), "=&v"(v1), "=&v"(v2), "=&v"(v3), "=&v"(v4), "=&v"(v5), "=&v"(v6), "=&v"(v7)
        : "v"(addr), "v"(p0), "v"(p1)
        : "memory");
}
template <int MODE> DI void attn_pass(LAS unsigned char* L, const bf16_t* Kg, const bf16_t* VTg, int qb, u64 selm, u64 um, int tl64, const bf16x8 (&qf)[8],
                                      f32x16 (&O)[4], float& lsum, float moff, int tid) {
    const int lane = tid & 63, c = lane & 31, hf = lane >> 5;
    lsum = 0.f;
#pragma unroll
    for (int d = 0; d < 4; ++d) O[d] = zero16();
    int j = at_next((MODE ? (qb > 8 ? qb - 8 : 0) : 0) - 1, qb, um), buf = 0;
    u32x4 kr[2], vr[2];
    if (j <= qb) { at_load(Kg, VTg, j, tid, kr, vr); at_store(L, 0, tid, kr, vr); }
    __syncthreads();
    while (j <= qb) {
        const int jn = at_next(j, qb, um);
        if (jn <= qb) at_load(Kg, VTg, jn, tid, kr, vr);
        {
            const LAS unsigned char* Kt = L + AT_K + buf * 17408; const LAS unsigned char* Vt = L + AT_V + buf * 18432;
            const bool diag = (j == qb), first = MODE ? (j == qb - 8) : false, selb = MODE ? true : (((selm >> j) & 1ull) != 0ull);
            const float init = selb ? -moff : -__builtin_inff();
            const int tlh = tl64 - 4 * hf;
            float ps = 0.f; bf16x8 pk[2][2];
#pragma unroll
            for (int kt = 0; kt < 2; ++kt) {
                f32x16 sc;
#pragma unroll
                for (int i = 0; i < 16; ++i) sc[i] = init;
                qk_chain(sc, (unsigned)(unsigned long)(Kt + (kt * 32 + c) * 272 + hf * 16), qf);
                if (diag || first) {
#pragma unroll
                    for (int i = 0; i < 16; ++i) { const int k0 = kt * 32 + crow(i, 0); sc[i] = (diag ? (k0 <= tlh) : (k0 > tlh)) ? sc[i] : -__builtin_inff(); }
                }
#pragma unroll
                for (int i = 0; i < 16; ++i) { const float p = __builtin_amdgcn_exp2f(sc[i]); sc[i] = p; ps += p; }
                pk[kt][0] = pack8(sc, 0); pk[kt][1] = pack8(sc, 1);
            }
            lsum += ps;
#pragma unroll
            for (int kt = 0; kt < 2; ++kt)
                pv_chain(O[0], O[1], O[2], O[3], (unsigned)(unsigned long)(Vt + c * 144 + kt * 64 + hf * 16), pk[kt][0], pk[kt][1]);
        }
        if (jn <= qb) at_store(L, buf ^ 1, tid, kr, vr);
        __syncthreads();
        buf ^= 1; j = jn;
    }
    lsum += __shfl_xor(lsum, 32);
}
DI void attn_item(LAS unsigned char* L, const bf16_t* PROJ, const bf16_t* VT, const unsigned* SEL, bf16_t* OA, const float* moff, int item, int tid) {
    asm volatile("" : "+v"(tid));
    const int qb = 63 - (item >> 3), g = item & 3, bl = (item >> 2) & 1;
    const int w = tid >> 6, lane = tid & 63, c = lane & 31, hf = lane >> 5;
    const int tl64 = w * 8 + (c >> 2), r = c & 3, tok = bl * SEQ + qb * 64 + tl64, h = g * 4 + r;
    bf16x8 qf[8];
#pragma unroll
    for (int s = 0; s < 8; ++s) qf[s] = *(const bf16x8*)(PROJ + (size_t)tok * NP + h * 128 + 16 * s + 8 * hf);
    const u32x2 sm = *(const u32x2*)(SEL + ((size_t)tok * 4 + g) * 2);
    const u64 selm = (u64)sm[0] | ((u64)sm[1] << 32);
    unsigned ulo = sm[0], uhi = sm[1];
#pragma unroll
    for (int o = 1; o < 64; o <<= 1) { ulo |= __shfl_xor(ulo, o); uhi |= __shfl_xor(uhi, o); }
    LAS unsigned* misc = (LAS unsigned*)(L + AT_MISC);
    if (lane == 0) { misc[2 * w] = ulo; misc[2 * w + 1] = uhi; }
    __syncthreads();
    unsigned alo = 0u, ahi = 0u;
#pragma unroll
    for (int i = 0; i < 8; ++i) { alo |= misc[2 * i]; ahi |= misc[2 * i + 1]; }
    const u64 um = (u64)alo | ((u64)ahi << 32);
    const float g1 = sigm(bf2f(PROJ[(size_t)tok * NP + C_GATE + h * 3 + 1])), g2 = sigm(bf2f(PROJ[(size_t)tok * NP + C_GATE + h * 3 + 2]));
    f32x16 O[4]; float lsum;
    const bf16_t* pb = PROJ + (size_t)(bl * SEQ) * NP;
#pragma unroll 1
    for (int pass = 0; pass < 2; ++pass) {
        if (pass == 0) attn_pass<0>(L, pb + C_KV + (8 + g) * 128, VT + (size_t)((0 * 2 + bl) * 4 + g) * 128 * SEQ, qb, selm, um, tl64, qf, O, lsum, moff[1], tid);
        else attn_pass<1>(L, pb + C_KV + (16 + g) * 128, VT + (size_t)((1 * 2 + bl) * 4 + g) * 128 * SEQ, qb, ~0ull, ~0ull, tl64, qf, O, lsum, moff[2], tid);
        const float f = lsum > 0.f ? (pass ? g2 : g1) / lsum : 0.f;
#pragma unroll
        for (int d = 0; d < 4; ++d)
#pragma unroll
            for (int q = 0; q < 4; ++q) { bf16_t* op = OA + (size_t)tok * DM + h * 128 + d * 32 + 8 * q + 4 * hf; const u32x2 pr = *(const u32x2*)op;
                const float a0 = bflo(pr[0]) + O[d][4 * q] * f, a1 = bfhi(pr[0]) + O[d][4 * q + 1] * f, a2 = bflo(pr[1]) + O[d][4 * q + 2] * f, a3 = bfhi(pr[1]) + O[d][4 * q + 3] * f;
                *(u32x2*)op = (u32x2){pk2(a0, a1), pk2(a2, a3)}; }
    }
}

struct ScanFrag { u32x2 wf[2][2][2], qg[2][2][2], qk[2][2], kg[4][2], u[2][4]; float eg; };
DI void scan_load(ScanFrag& F, const bf16_t* GQG, const bf16_t* GKGT, const bf16_t* GW, const bf16_t* GUT, const bf16_t* GQK, const float* GEXP, size_t unit, int sl, int ww, int c, int hf) {
#pragma unroll
    for (int mt = 0; mt < 2; ++mt) {
#pragma unroll
        for (int s = 0; s < 2; ++s) { const size_t o = unit * 8192 + (size_t)(mt * 32 + c) * 128 + 32 * ww + 16 * s + 4 * hf;
            F.wf[mt][s][0] = *(const u32x2*)(GW + o); F.wf[mt][s][1] = *(const u32x2*)(GW + o + 8); F.qg[mt][s][0] = *(const u32x2*)(GQG + o); F.qg[mt][s][1] = *(const u32x2*)(GQG + o + 8); }
        { const size_t o = unit * 4096 + (size_t)(mt * 32 + c) * 64 + 16 * ww + 4 * hf; F.qk[mt][0] = *(const u32x2*)(GQK + o); F.qk[mt][1] = *(const u32x2*)(GQK + o + 8); }
#pragma unroll
        for (int q = 0; q < 4; ++q) F.u[mt][q] = *(const u32x2*)(GUT + unit * 8192 + (size_t)(sl * 32 + c) * 64 + mt * 32 + 8 * q + 4 * hf);
    }
#pragma unroll
    for (int s = 0; s < 4; ++s) { const size_t o = unit * 8192 + (size_t)(32 * ww + c) * 64 + 16 * s + 4 * hf; F.kg[s][0] = *(const u32x2*)(GKGT + o); F.kg[s][1] = *(const u32x2*)(GKGT + o + 8); }
    F.eg = GEXP[unit];
}
DI void scan_step(const ScanFrag& F, f32x16& st, LAS float* P1, LAS float* OB, bf16_t* GUT, size_t unit, int sl, int ww, int lane, int tl, bool active) {
    bf16x8 sf[2]; sf[0] = pack8(st, 0); sf[1] = pack8(st, 1);
    if (active) {
#pragma unroll
    for (int mt = 0; mt < 2; ++mt) { f32x16 p = zero16(); p = mfma32(cat8(F.wf[mt][0][0], F.wf[mt][0][1]), sf[0], p); p = mfma32(cat8(F.wf[mt][1][0], F.wf[mt][1][1]), sf[1], p);
#pragma unroll
        for (int i = 0; i < 16; ++i) P1[((ww * 2 + mt) * 16 + i) * 64 + lane] = p[i]; }
    }
    __syncthreads();
    if (active) {
    f32x16 u[2]; bf16x8 vf[2][2];
#pragma unroll
    for (int mt = 0; mt < 2; ++mt) {
#pragma unroll
        for (int q = 0; q < 4; ++q) { u[mt][4 * q] = bflo(F.u[mt][q][0]); u[mt][4 * q + 1] = bfhi(F.u[mt][q][0]); u[mt][4 * q + 2] = bflo(F.u[mt][q][1]); u[mt][4 * q + 3] = bfhi(F.u[mt][q][1]); }
#pragma unroll
        for (int i = 0; i < 16; ++i) { float sm = 0.f;
#pragma unroll
            for (int w2 = 0; w2 < 4; ++w2) sm += P1[((w2 * 2 + mt) * 16 + i) * 64 + lane];
            u[mt][i] -= sm; }
        vf[mt][0] = pack8(u[mt], 0); vf[mt][1] = pack8(u[mt], 1);
    }
    const bf16x8 vsel = (ww == 0) ? vf[0][0] : (ww == 1) ? vf[0][1] : (ww == 2) ? vf[1][0] : vf[1][1];
#pragma unroll
    for (int mt = 0; mt < 2; ++mt) { f32x16 o = zero16(); o = mfma32(cat8(F.qg[mt][0][0], F.qg[mt][0][1]), sf[0], o); o = mfma32(cat8(F.qg[mt][1][0], F.qg[mt][1][1]), sf[1], o); o = mfma32(cat8(F.qk[mt][0], F.qk[mt][1]), vsel, o);
#pragma unroll
        for (int i = 0; i < 16; ++i) OB[((ww * 2 + mt) * 16 + i) * 64 + lane] = o[i]; }
#pragma unroll
    for (int i = 0; i < 16; ++i) st[i] *= F.eg;
#pragma unroll
    for (int s = 0; s < 4; ++s) st = mfma32(cat8(F.kg[s][0], F.kg[s][1]), vf[s >> 1][s & 1], st);
    }
    __syncthreads();
    if (active) {
    const int l2 = tl & 63, q = tl >> 6;
#pragma unroll
    for (int mt = 0; mt < 2; ++mt) { float o4[4];
#pragma unroll
        for (int e = 0; e < 4; ++e) { float sm = 0.f;
#pragma unroll
            for (int w2 = 0; w2 < 4; ++w2) sm += OB[((w2 * 2 + mt) * 16 + 4 * q + e) * 64 + l2];
            o4[e] = sm; }
        *(u32x2*)(GUT + unit * 8192 + (size_t)(sl * 32 + (l2 & 31)) * 64 + mt * 32 + 8 * q + 4 * (l2 >> 5)) = (u32x2){pk2(o4[0], o4[1]), pk2(o4[2], o4[3])}; }
    }
}
DI void gdn_scan(LAS unsigned char* L, const bf16_t* GQG, const bf16_t* GKGT, const bf16_t* GW, bf16_t* GUT, const bf16_t* GQK, const float* GEXP, int su, int tid) {
    const int w = tid >> 6, lane = tid & 63, c = lane & 31, hf = lane >> 5, ww = w & 3, tl = tid & 255;
    const bool active = w < 4;
    const int sl = su & 3, h = (su >> 2) & 15, bl = su >> 6;
    LAS float* P1 = (LAS float*)L; LAS float* OB = (LAS float*)(L + 32768);
    f32x16 st = zero16();
    ScanFrag A, B;
    if (active) scan_load(A, GQG, GKGT, GW, GUT, GQK, GEXP, (size_t)((bl * 64 + 0) * 16 + h), sl, ww, c, hf);
#pragma unroll 1
    for (int n = 0; n < 64; n += 2) {
        const size_t u0 = (size_t)((bl * 64 + n) * 16 + h), u1 = u0 + 16, u2 = u0 + 32;
        if (active) scan_load(B, GQG, GKGT, GW, GUT, GQK, GEXP, u1, sl, ww, c, hf);
        scan_step(A, st, P1, OB, GUT, u0, sl, ww, lane, tl, active);
        if (active && n + 2 < 64) scan_load(A, GQG, GKGT, GW, GUT, GQK, GEXP, u2, sl, ww, c, hf);
        scan_step(B, st, P1, OB, GUT, u1, sl, ww, lane, tl, active);
    }
    __syncthreads();
}
constexpr int SC_W = 0, SC_QG = 17408, SC_KG = 34816, SC_QK = 53248, SC_BUF = 62464;
DI void scan2_ld(u32x4 (&r)[14], const bf16_t* GQG, const bf16_t* GKGT, const bf16_t* GW, const bf16_t* GQK, size_t unit, int lt) {
#pragma unroll
    for (int i = 0; i < 4; ++i) { const int cc = lt + 256 * i; r[i] = *(const u32x4*)(GW + unit * 8192 + cc * 8); r[4 + i] = *(const u32x4*)(GQG + unit * 8192 + cc * 8); r[8 + i] = *(const u32x4*)(GKGT + unit * 8192 + cc * 8); }
#pragma unroll
    for (int i = 0; i < 2; ++i) { const int cc = lt + 256 * i; r[12 + i] = *(const u32x4*)(GQK + unit * 4096 + cc * 8); }
}
DI void scan2_put(LAS unsigned char* d, const u32x4& v) { *(LAS u32x2*)d = (u32x2){v[0], v[1]}; *(LAS u32x2*)(d + 16) = (u32x2){v[2], v[3]}; }
DI void scan2_st(LAS unsigned char* B, const u32x4 (&r)[14], int lt) {
#pragma unroll
    for (int i = 0; i < 4; ++i) { const int cc = lt + 256 * i;
        { const int row = cc >> 4, part = cc & 15, o = row * 272 + (part >> 1) * 32 + (part & 1) * 8; scan2_put(B + SC_W + o, r[i]); scan2_put(B + SC_QG + o, r[4 + i]); }
        { const int row = cc >> 3, part = cc & 7; scan2_put(B + SC_KG + row * 144 + (part >> 1) * 32 + (part & 1) * 8, r[8 + i]); } }
#pragma unroll
    for (int i = 0; i < 2; ++i) { const int cc = lt + 256 * i, row = cc >> 3, part = cc & 7; scan2_put(B + SC_QK + row * 144 + (part >> 1) * 32 + (part & 1) * 8, r[12 + i]); }
}
DI void gdn_scan2(LAS unsigned char* L, const bf16_t* GQG, const bf16_t* GKGT, const bf16_t* GW, bf16_t* GUT, const bf16_t* GQK, const float* GEXP, int su, int tid) {
    const int w = tid >> 6, lane = tid & 63, c = lane & 31, hf = lane >> 5, h = su & 15, bl = su >> 4;
#define SC_UNIT(n) ((size_t)((bl * 64 + (n)) * 16 + h))
    if (w >= 4) {
        const int lt = tid - 256; u32x4 r[14];
        scan2_ld(r, GQG, GKGT, GW, GQK, SC_UNIT(0), lt); scan2_st(L, r, lt);
        scan2_ld(r, GQG, GKGT, GW, GQK, SC_UNIT(1), lt);
        __syncthreads();
#pragma unroll 1
        for (int n = 0; n < 64; ++n) {
            if (n + 1 < 64) scan2_st(L + ((n + 1) & 1) * SC_BUF, r, lt);
            if (n + 2 < 64) scan2_ld(r, GQG, GKGT, GW, GQK, SC_UNIT(n + 2), lt);
            __syncthreads();
        }
    } else {
        const int sl = w; f32x16 st[4]; u32x2 un[2][4]; float egn;
#pragma unroll
        for (int t = 0; t < 4; ++t) st[t] = zero16();
#pragma unroll
        for (int mt = 0; mt < 2; ++mt)
#pragma unroll
            for (int q = 0; q < 4; ++q) un[mt][q] = *(const u32x2*)(GUT + SC_UNIT(0) * 8192 + (size_t)(sl * 32 + c) * 64 + mt * 32 + 8 * q + 4 * hf);
        egn = GEXP[SC_UNIT(0)];
        __syncthreads();
#pragma unroll 1
        for (int n = 0; n < 64; ++n) {
            const LAS unsigned char* B = L + (n & 1) * SC_BUF; const size_t unit = SC_UNIT(n);
            f32x16 vn[2]; const float eg = egn;
#pragma unroll
            for (int mt = 0; mt < 2; ++mt)
#pragma unroll
                for (int q = 0; q < 4; ++q) { vn[mt][4 * q] = bflo(un[mt][q][0]); vn[mt][4 * q + 1] = bfhi(un[mt][q][0]); vn[mt][4 * q + 2] = bflo(un[mt][q][1]); vn[mt][4 * q + 3] = bfhi(un[mt][q][1]); }
            if (n + 1 < 64) {
#pragma unroll
                for (int mt = 0; mt < 2; ++mt)
#pragma unroll
                    for (int q = 0; q < 4; ++q) un[mt][q] = *(const u32x2*)(GUT + SC_UNIT(n + 1) * 8192 + (size_t)(sl * 32 + c) * 64 + mt * 32 + 8 * q + 4 * hf);
                egn = GEXP[SC_UNIT(n + 1)];
            }
            bf16x8 sf[4][2];
#pragma unroll
            for (int t = 0; t < 4; ++t) { sf[t][0] = pack8(st[t], 0); sf[t][1] = pack8(st[t], 1); }
#pragma unroll
            for (int mt = 0; mt < 2; ++mt) { f32x16 p = zero16();
#pragma unroll
                for (int t = 0; t < 4; ++t)
#pragma unroll
                    for (int s = 0; s < 2; ++s) p = mfma32(*(const LAS bf16x8*)(B + SC_W + (mt * 32 + c) * 272 + (2 * t + s) * 32 + hf * 16), sf[t][s], p);
#pragma unroll
                for (int i = 0; i < 16; ++i) vn[mt][i] -= p[i]; }
            bf16x8 vf[2][2];
#pragma unroll
            for (int mt = 0; mt < 2; ++mt) { vf[mt][0] = pack8(vn[mt], 0); vf[mt][1] = pack8(vn[mt], 1); }
#pragma unroll
            for (int mt = 0; mt < 2; ++mt) { f32x16 o = zero16();
#pragma unroll
                for (int t = 0; t < 4; ++t)
#pragma unroll
                    for (int s = 0; s < 2; ++s) o = mfma32(*(const LAS bf16x8*)(B + SC_QG + (mt * 32 + c) * 272 + (2 * t + s) * 32 + hf * 16), sf[t][s], o);
#pragma unroll
                for (int j = 0; j < 4; ++j) o = mfma32(*(const LAS bf16x8*)(B + SC_QK + (mt * 32 + c) * 144 + j * 32 + hf * 16), vf[j >> 1][j & 1], o);
#pragma unroll
                for (int q = 0; q < 4; ++q) *(u32x2*)(GUT + unit * 8192 + (size_t)(sl * 32 + c) * 64 + mt * 32 + 8 * q + 4 * hf) = (u32x2){pk2(o[4 * q], o[4 * q + 1]), pk2(o[4 * q + 2], o[4 * q + 3])}; }
#pragma unroll
            for (int t = 0; t < 4; ++t) {
#pragma unroll
                for (int i = 0; i < 16; ++i) st[t][i] *= eg;
#pragma unroll
                for (int j = 0; j < 4; ++j) st[t] = mfma32(*(const LAS bf16x8*)(B + SC_KG + (32 * t + c) * 144 + j * 32 + hf * 16), vf[j >> 1][j & 1], st[t]); }
            __syncthreads();
        }
    }
#undef SC_UNIT
    __syncthreads();
}
DI void obnorm_item(LAS unsigned char* L, const bf16_t* GUT, const bf16_t* PROJ, const float* ogain, bf16_t* OBm, int unit, int tid) {
    const int h = unit & 15, n = (unit >> 4) & 63, bl = unit >> 10;
#pragma unroll
    for (int i = 0; i < 2; ++i) { const int cc = tid + 512 * i, d = cc >> 3, part = cc & 7; const u32x4 v = *(const u32x4*)(GUT + (size_t)unit * 8192 + d * 64 + part * 8);
        LAS unsigned* dp = (LAS unsigned*)(L + d * 132 + part * 16); dp[0] = v[0]; dp[1] = v[1]; dp[2] = v[2]; dp[3] = v[3]; }
    __syncthreads();
#pragma unroll
    for (int i = 0; i < 2; ++i) {
        const int wi = tid + 512 * i, t = wi >> 4, dvg = wi & 15; const size_t tok = (size_t)(bl * SEQ + n * 64 + t);
        const u32x4 zr = *(const u32x4*)(PROJ + tok * NP + C_Z + h * 128 + dvg * 8);
        const f32x4 ga = *(const f32x4*)(ogain + dvg * 8), gb = *(const f32x4*)(ogain + dvg * 8 + 4);
        float v[8], ss = 0.f;
#pragma unroll
        for (int e = 0; e < 8; ++e) { v[e] = bf2f(*(const LAS bf16_t*)(L + (dvg * 8 + e) * 132 + t * 2)); ss += v[e] * v[e]; }
        const float rs = rsqrtf(sum16(ss) * (1.0f / 128.0f) + EPS);
        u32x4 o;
        o[0] = pk2(v[0] * rs * ga[0] * silu(bflo(zr[0])), v[1] * rs * ga[1] * silu(bfhi(zr[0]))); o[1] = pk2(v[2] * rs * ga[2] * silu(bflo(zr[1])), v[3] * rs * ga[3] * silu(bfhi(zr[1])));
        o[2] = pk2(v[4] * rs * gb[0] * silu(bflo(zr[2])), v[5] * rs * gb[1] * silu(bfhi(zr[2]))); o[3] = pk2(v[6] * rs * gb[2] * silu(bflo(zr[3])), v[7] * rs * gb[3] * silu(bfhi(zr[3])));
        *(u32x4*)(OBm + tok * DM + h * 128 + dvg * 8) = o;
    }
    __syncthreads();
}

typedef __attribute__((address_space(1))) unsigned char* gptr_t;
DI unsigned char* opq(unsigned char* q) { gptr_t g = (gptr_t)q; asm volatile("" : "+s"(g)); return (unsigned char*)g; }
#define GIN(k) ((const float*)(const __attribute__((address_space(1))) float*)(pp->in[k]))
#define WSB opq(pp->ws)
#define DOB opq((unsigned char*)pp->out)
#define WAT ((bf16_t*)(WSB + WS_WAT))
#define WBT ((bf16_t*)(WSB + WS_WBT))
#define WOT ((bf16_t*)(WSB + WS_WOT))
#define WCT ((bf16_t*)(WSB + WS_WCT))
#define CMPC ((float*)(WSB + WS_CMPC))
#define CTR ((unsigned*)(WSB + WS_CTR))
#define KC ((bf16_t*)(WSB + WS_KC))
#define VCT ((bf16_t*)(WSB + WS_VCT))
#define SEL ((unsigned*)(WSB + WS_SEL))
#define GEXP ((float*)(WSB + WS_GEXP))
#define H ((bf16_t*)(WSB + WS_H))
#define WINT ((bf16_t*)(WSB + WS_WINT))
#define GQG ((bf16_t*)(WSB + WS_GQG))
#define GKGT ((bf16_t*)(WSB + WS_GKGT))
#define GW ((bf16_t*)(WSB + WS_GW))
#define PROJ ((bf16_t*)(WSB + WS_PROJ))
#define GUT ((bf16_t*)(WSB + WS_GU))
#define GQK ((bf16_t*)(WSB + WS_GQK))
#define VT ((bf16_t*)(WSB + WS_VT))
#define X1 ((float*)(WSB + WS_X1))
#define H2 ((bf16_t*)(WSB + WS_H2))
#define WGT ((bf16_t*)(WSB + WS_WGT))
#define WDT ((bf16_t*)(WSB + WS_WDT))
#define ACT ((bf16_t*)(WSB + WS_ACT))
#define OA ((bf16_t*)(DOB + DO_OA))
#define OBm ((bf16_t*)(DOB + DO_OB))
#define MIX ((bf16_t*)(DOB + DO_MIX))

typedef const Params __attribute__((address_space(4)))* ParamsK;
template <int PH> DI void run_phase(int half, LAS unsigned char* L) {
    ParamsK pp = (ParamsK)__builtin_amdgcn_kernarg_segment_ptr(); asm volatile("" : "+s"(pp));
    int tid = threadIdx.x, bid = blockIdx.x, G = gridDim.x;
    asm volatile("" : "+v"(tid)); asm volatile("" : "+s"(bid)); asm volatile("" : "+s"(G)); asm volatile("" : "+s"(half));
    LAS float* tile = (LAS float*)L;
    if (PH == 0) {
        if (bid == 0 && tid < 32) CTR[tid] = 0u;
        if (bid == 0 && tid == 32) CTR[64] = 0u;
        if (bid == 1 && tid < 64) {
            const float* qg = GIN(3); const float* kg = GIN(4);
            float mq = fmaxf(fabsf(qg[tid]), fabsf(qg[tid + 64]));
#pragma unroll
            for (int o = 32; o; o >>= 1) mq = fmaxf(mq, __shfl_xor(mq, o));
#pragma unroll
            for (int br = 0; br < 3; ++br) { float mk = fmaxf(fabsf(kg[br * 128 + tid]), fabsf(kg[br * 128 + tid + 64]));
#pragma unroll
                for (int o = 32; o; o >>= 1) mk = fmaxf(mk, __shfl_xor(mk, o));
                if (tid == 0) ((float*)(CTR + 40))[br] = QSCALE * 128.0f * mq * mk; }
        }
        xpose_all<0>(tile, GIN(11), 2048, 2048, WAT, tid, bid, G);
        xpose_all<0>(tile, GIN(12), 2048, 2048, WBT, tid, bid, G);
        xpose_all<0>(tile, GIN(13), 2048, 2048, WOT, tid, bid, G);
        xpose_all<0>(tile, GIN(6), 4096, 128, WCT, tid, bid, G);
        xpose_all<0>(tile, GIN(6) + 4096 * 128, 4096, 128, WCT + 128 * 4096, tid, bid, G);
        xpose_all<1>(tile, GIN(2), 2048, 17488, WINT, tid, bid, G);
        norm_rows(GIN(0), GIN(1), H, TH, tid, bid, G);
        if (bid >= G - 16) {
            const int idx = bid - (G - 16), kv = idx >> 3, ks = idx & 7, e = tid & 127, part = tid >> 7;
            const float* pos = GIN(5) + kv * 4096 + ks * 512 + part * 128; const float* wc = GIN(6) + ((size_t)kv * 4096 + ks * 512 + part * 128) * 128 + e;
            float s[8];
#pragma unroll
            for (int j = 0; j < 8; ++j) s[j] = 0.f;
#pragma unroll 1
            for (int k = 0; k < 128; k += 8) {
#pragma unroll
                for (int j = 0; j < 8; ++j) s[j] += pos[k + j] * wc[(size_t)(k + j) * 128];
            }
            tile[tid] = ((s[0] + s[1]) + (s[2] + s[3])) + ((s[4] + s[5]) + (s[6] + s[7])); __syncthreads();
            if (tid < 128) CMPC[(kv * 8 + ks) * 128 + tid] = tile[tid] + tile[tid + 128] + tile[tid + 256] + tile[tid + 384];
            __syncthreads();
        }
    }
    if (PH == 1) { if (half == 0) norm_rows(GIN(0) + (size_t)TH * DM, GIN(1), H, TH, tid, bid, G); }
    if (PH == 2) { EpiProj E{PROJ}; run_gemm(L, H, WINT, TH, NP, 2048, E); }
    if (PH == 3) {
        LAS int* qw = (LAS int*)(L + 131072 + 64);
        int nxt = 0;
        if (tid == 0) nxt = (int)atomicAdd(CTR + 2 + half, 1u);
        for (;;) {
            if (tid == 0) *qw = nxt;
            __syncthreads();
            const int it = *qw;
            __syncthreads();
            if (it >= 64 + 2048 + 1024 + 512) break;
            if (tid == 0) nxt = (int)atomicAdd(CTR + 2 + half, 1u);
            if (it < 64) cmp_item(L, PROJ, WCT, CMPC, GIN(4), KC, VCT, it, tid);
            else if (it < 64 + 2048) gdn_prep_item(L, PROJ, GIN(7), GIN(8), GIN(9), GQG, GKGT, GW, GUT, GQK, GEXP, it - 64, tid);
            else if (it < 64 + 2048 + 1024) vt_item(L, PROJ, VT, it - 64 - 2048, tid);
            else qk_norm_item(PROJ, GIN(3), GIN(4), it - 64 - 2048 - 1024, tid);
        }
    }
    if (PH == 6) for (int it = bid; it < 512; it += G) cmp_attn_item(L, PROJ, KC, VCT, OA, SEL, (const float*)(CTR + 40), it, tid);
    if (PH == 7) { if (bid < 32) gdn_scan2(L, GQG, GKGT, GW, GUT, GQK, GEXP, bid, tid); }
    if (PH == 8) {
        int k = 0;
        for (;;) {
            LAS int* qw = (LAS int*)(L + AT_MISC + 64);
            if (tid == 0) { int it = -1;
                while (k < 8) { const int q = (bid + k) & 7; const unsigned t = atomicAdd(CTR + 8 + 8 * half + q, 1u); if (t < 64u) { it = (int)t * 8 + q; break; } ++k; }
                *qw = it; }
            __syncthreads();
            const int it = *qw;
            __syncthreads();
            if (it < 0) break;
            attn_item(L, PROJ, VT, SEL, OA, (const float*)(CTR + 40), it, tid);
        }
    }
    if (PH == 9) for (int it = bid; it < 2048; it += G) obnorm_item(L, GUT, PROJ, GIN(10), OBm, it, tid);
    if (PH == 10) {
        EpiMix2 E{MIX + (size_t)half * TH * DM, PROJ};
        pg8::Gemm g{OA, WAT, 2 * TH, 4096, 2048}; BrOrder S; S.init(TH, 2048, (int)gridDim.x, (int)blockIdx.x);
        pg8::gemm_phase<EpiMix2, BrOrder, false>((PG8_LAS unsigned char*)L, g, S, E, nullptr);
        __syncthreads();
    }
    if (PH == 12) {
        xpose_all<2>(tile, GIN(15), 2048, DFF, WGT, tid, bid, G, GIN(14));
        xpose_all<3>(tile, GIN(16), 2048, DFF, WGT, tid, bid, G, GIN(14));
        xpose_all<0>(tile, GIN(17), DFF, 2048, WDT, tid, bid, G);
    }
    if (PH == 13) { EpiResX E{X1, GIN(0), H2, (float*)(WSB + WS_SSQ)}; run_gemm_half(L, MIX, WOT, 2 * TH, 2048, 2048, E); }
    if (PH == 14) {
        const float* ssq = (const float*)(WSB + WS_SSQ); float* rs = (float*)(WSB + WS_RSTD);
        for (int row = bid * 512 + tid; row < 2 * TH; row += G * 512) { float t = 0.f;
#pragma unroll
            for (int j = 0; j < 8; ++j) { const f32x4 v = *(const f32x4*)(ssq + (size_t)row * 32 + j * 4); t += (v[0] + v[1]) + (v[2] + v[3]); }
            rs[row] = rsqrtf(t * (1.0f / DM) + EPS); }
    }
    if (PH == 15) { EpiGU2 E{ACT, (const float*)(WSB + WS_RSTD)}; run_gemm(L, H2, WGT, 2 * TH, 2 * DFF, 2048, E); }
    if (PH == 16) { EpiRes E{(float*)(__attribute__((address_space(1))) float*)pp->out, X1}; run_gemm_half(L, ACT, WDT, 2 * TH, 2048, DFF, E); }
}
constexpr int LDS_BYTES = 132 * 1024;
DI void gbar(unsigned* bar, unsigned target) {
    asm volatile("s_waitcnt vmcnt(0) lgkmcnt(0)" ::: "memory");
    __syncthreads();
    if (threadIdx.x == 0) {
        __builtin_amdgcn_fence(__ATOMIC_RELEASE, "agent");
        asm volatile("s_waitcnt vmcnt(0)" ::: "memory");
        __hip_atomic_fetch_add(bar, 1u, __ATOMIC_RELAXED, __HIP_MEMORY_SCOPE_AGENT);
        while (__hip_atomic_load(bar, __ATOMIC_RELAXED, __HIP_MEMORY_SCOPE_AGENT) < target) __builtin_amdgcn_s_sleep(1);
        __builtin_amdgcn_fence(__ATOMIC_ACQUIRE, "agent");
        asm volatile("s_waitcnt vmcnt(0)" ::: "memory");
    }
    __syncthreads();
}
#ifndef PROBE_PH
#define PROBE_PH -1
#endif
#define RP(X, h) do { if (PROBE_PH == (X)) { const unsigned long long t0_ = __builtin_amdgcn_s_memrealtime(); run_phase<X>(h, L); const unsigned long long t1_ = __builtin_amdgcn_s_memrealtime(); \
    while (__builtin_amdgcn_s_memrealtime() - t1_ < t1_ - t0_) __builtin_amdgcn_s_sleep(8); } else run_phase<X>(h, L); } while (0)
__global__ void __launch_bounds__(512, 2) mega(Params p) {
    extern __shared__ __attribute__((aligned(16))) unsigned char smem[];
    LAS unsigned char* L = (LAS unsigned char*)smem;
    cg::grid_group grid = cg::this_grid();
    unsigned nbar = 0u; unsigned* gbar_word;
    { ParamsK pp = (ParamsK)__builtin_amdgcn_kernarg_segment_ptr(); gbar_word = (unsigned*)(__attribute__((address_space(1))) unsigned*)(pp->ws + WS_CTR) + 64; }
#define GB() do { nbar += gridDim.x; gbar(gbar_word, nbar); } while (0)
    RP(0, 0); grid.sync();
#pragma unroll 1
    for (int half = 0; half < 2; ++half) {
        RP(2, half); GB();
        RP(3, half); GB();
        RP(6, half); GB();
        RP(7, half); RP(8, half); GB();
        RP(9, half); RP(1, half); GB();
        RP(10, half); GB();
    }
    RP(12, 0); RP(13, 0); GB();
    RP(14, 0); GB();
    RP(15, 0); GB();
    RP(16, 0);
}
extern "C" void kernel_launch(void* const* d_in, const int* in_sizes, int n_in, void* d_out, int out_size, void* d_ws, size_t ws_size, hipStream_t stream) {
    static int grid = 0;
    if (grid == 0) {
        int dev = 0, cus = 0, per_cu = 0;
        (void)hipGetDevice(&dev); (void)hipDeviceGetAttribute(&cus, hipDeviceAttributeMultiprocessorCount, dev);
        if (hipFuncSetAttribute((const void*)mega, hipFuncAttributeMaxDynamicSharedMemorySize, LDS_BYTES) != hipSuccess) fprintf(stderr, "hipFuncSetAttribute failed\n");
        if (hipOccupancyMaxActiveBlocksPerMultiprocessor(&per_cu, (const void*)mega, 512, LDS_BYTES) != hipSuccess || per_cu < 1) { fprintf(stderr, "occupancy query: %d\n", per_cu); per_cu = 1; }
        (void)hipGetLastError();
        grid = cus;
    }
    Params p{};
    for (int i = 0; i < 18; ++i) p.in[i] = (const float*)d_in[i];
    p.out = (float*)d_out; p.ws = (unsigned char*)d_ws;
    void* args[] = {&p};
    hipError_t e = hipLaunchCooperativeKernel((const void*)mega, dim3(grid), dim3(512), args, LDS_BYTES, stream);
    if (e != hipSuccess) fprintf(stderr, "cooperative launch failed: %s (grid %d)\n", hipGetErrorString(e), grid);
}
```

```cpp
#include <hip/hip_runtime.h>
#include <hip/hip_cooperative_groups.h>
#include <cstdio>
namespace cg = cooperative_groups;
namespace pg8 {
#define PG8_LAS __attribute__((address_space(3)))
typedef unsigned short bf16_t;
typedef short bf16x8 __attribute__((ext_vector_type(8)));
typedef float f32x4 __attribute__((ext_vector_type(4)));
typedef unsigned u32x4 __attribute__((ext_vector_type(4)));
constexpr int BM = 256, BK = 64, HALF = 128, HTB = HALF * BK * 2  , STAGE_BYTES = 8 * HTB, NXCD = 8, WGM = 8;

__host__ __device__ __forceinline__ int lds_byte(int r, int c) { const int st = (r >> 4) * 2 + (c >> 5), rr = r & 15, cc = c & 31, ob = rr * 64 + cc * 2; return st * 1024 + (ob ^ (((ob >> 9) & 1) << 5)); }
__host__ __device__ __forceinline__ void stage_rc(int b, int& R, int& C) { const int st = b / 1024, sb = b % 1024, swz = sb ^ (((sb >> 9) & 1) << 5); R = (st >> 1) * 16 + swz / 64; C = (st & 1) * 32 + (swz % 64) / 2; }
__host__ __device__ __forceinline__ int perm32(int rho) { const int n = rho >> 4, i = rho & 15; return 8 * (i >> 2) + 4 * n + (i & 3); }

struct Unit { int pm, pn; };
struct Gemm { const bf16_t* A; const bf16_t* Bt; int M, N, K; };

struct StaticOrder {
    int nM, nN, nwg, G, c;
    __host__ __device__ void init(int M, int N, int G_, int c_) { nM = M / BM; nN = N / BM; nwg = nM * nN; G = G_; c = c_; }
    __host__ __device__ bool next(int i, Unit& u) const {
        const long L = (long)i * G + c; if (L >= nwg) return false;
        int wgid = (int)L; { const int q = nwg / NXCD, r = nwg % NXCD, xcd = wgid % NXCD, off = wgid / NXCD; wgid = (xcd < r ? xcd * (q + 1) : r * (q + 1) + (xcd - r) * q) + off; }
        const int nig = WGM * nN, gid = wgid / nig, fm = gid * WGM, gsz = (nM - fm) < WGM ? (nM - fm) : WGM;
        u.pm = fm + ((wgid % nig) % gsz); u.pn = (wgid % nig) / gsz; return true;
    }
    __device__ __forceinline__ void a_ready(const Unit&) const {}
    __device__ __forceinline__ void done(const Unit&) const {}
};
__device__ __forceinline__ unsigned cvt_pk_bf16(float lo, float hi) { unsigned r; asm volatile("v_cvt_pk_bf16_f32 %0, %1, %2" : "=v"(r) : "v"(lo), "v"(hi)); return r; }

template <class Epi, class Sched, bool STAMP = false>
__device__ __forceinline__ void gemm_phase(PG8_LAS unsigned char* lds, const Gemm g, const Sched& S, const Epi& E, unsigned long long* stamps) {
    int tid_ = threadIdx.x; asm volatile("" : "+v"(tid_));
    const int tid = tid_, wid = __builtin_amdgcn_readfirstlane(tid >> 6), lane = tid & 63, wr = wid >> 2, wc = wid & 3, fr = lane & 15, fq = lane >> 4;
    const int K = g.K, nt = K / BK;
    int ts_lo = 0, ts_hi = 0, nts = 0; const unsigned long long rt_entry = STAMP ? (unsigned long long)wall_clock64() : 0ull;
#define PG8_STAMP() do { if (STAMP && wid == 0 && nts < 64) { const unsigned long long _c = (unsigned long long)clock64(); \
        ts_lo = (lane == nts) ? (int)(unsigned)_c : ts_lo; ts_hi = (lane == nts) ? (int)(unsigned)(_c >> 32) : ts_hi; ++nts; } } while (0)
    PG8_STAMP();
    unsigned voffA[2], voffB[2];
#pragma unroll
    for (int i = 0; i < 2; ++i) { int R, C; stage_rc(tid * 16 + i * 8192, R, C); const int Rb = Epi::PERM ? ((R & ~31) + perm32(R & 31)) : R;
        voffA[i] = (unsigned)(R * K + C) * 2u; voffB[i] = (unsigned)(Rb * K + C) * 2u; }
    const size_t kstep = (size_t)(BK * 2);
    const size_t hstep = (size_t)HALF * K * 2;
    const size_t tstep = 2 * hstep;
    const unsigned ldsw = (unsigned)wid * 1024u;
    const int aoff = lds_byte(wr * 64 + fr, fq * 8), boff = lds_byte(wc * 32 + fr, fq * 8);
#define PG8_SA(b, h) (((b) * 2 + (h)) * HTB)
#define PG8_SB(b, h) ((4 + (b) * 2 + (h)) * HTB)
#define PG8_STAGE(bufoff, gbase, voff) do { _Pragma("unroll") for (int _i = 0; _i < 2; ++_i) \
        __builtin_amdgcn_global_load_lds((const unsigned*)((const char*)(gbase) + (voff)[_i]), (PG8_LAS unsigned*)(lds + (bufoff) + ldsw + _i * 8192), 16, 0, 0); } while (0)
#define PG8_LDA(dst, b, h) do { _Pragma("unroll") for (int m = 0; m < 4; ++m) _Pragma("unroll") for (int k = 0; k < 2; ++k) dst[m][k] = *(const PG8_LAS bf16x8*)(lds + PG8_SA(b, h) + aoff + m * 2048 + k * 1024); } while (0)
#define PG8_LDB(dst, b, h) do { _Pragma("unroll") for (int n = 0; n < 2; ++n) _Pragma("unroll") for (int k = 0; k < 2; ++k) dst[n][k] = *(const PG8_LAS bf16x8*)(lds + PG8_SB(b, h) + boff + n * 2048 + k * 1024); } while (0)
#define PG8_MMA(ai, bj, At, Bt) do { __builtin_amdgcn_s_setprio(1); _Pragma("unroll") for (int m = 0; m < 4; ++m) _Pragma("unroll") for (int n = 0; n < 2; ++n) _Pragma("unroll") for (int k = 0; k < 2; ++k) \
        acc[ai][bj][m][n] = __builtin_amdgcn_mfma_f32_16x16x32_bf16(Bt[n][k], At[m][k], acc[ai][bj][m][n], 0, 0, 0); __builtin_amdgcn_s_setprio(0); } while (0)
#define PG8_WAIT_V(n) asm volatile("s_waitcnt vmcnt(" #n ")" ::: "memory")
#define PG8_WAIT_L(n) asm volatile("s_waitcnt lgkmcnt(" #n ")" ::: "memory")
#define PG8_BAR __builtin_amdgcn_s_barrier()
#define PG8_SCHED __builtin_amdgcn_sched_barrier(0)
    Unit cur, nxt; int ui = 0;
    if (!S.next(0, cur)) return;
    f32x4 acc[2][2][4][2];
#pragma unroll
    for (int a = 0; a < 2; ++a)
#pragma unroll
        for (int b = 0; b < 2; ++b)
#pragma unroll
            for (int m = 0; m < 4; ++m)
#pragma unroll
                for (int n = 0; n < 2; ++n) acc[a][b][m][n] = (f32x4){0.f, 0.f, 0.f, 0.f};
    bf16x8 At[4][2], B0[2][2], B1[2][2];
    const char* cA = (const char*)g.A + (size_t)cur.pm * tstep; const char* cB = (const char*)g.Bt + (size_t)cur.pn * tstep;
    S.a_ready(cur);
    PG8_STAGE(PG8_SB(0, 0), cB, voffB); PG8_STAGE(PG8_SA(0, 0), cA, voffA); PG8_STAGE(PG8_SB(0, 1), cB + hstep, voffB); PG8_STAGE(PG8_SA(0, 1), cA + hstep, voffA);
    if (wr == 1) PG8_BAR;
    PG8_WAIT_V(4); PG8_BAR;
    PG8_STAGE(PG8_SB(1, 0), cB + kstep, voffB); PG8_STAGE(PG8_SA(1, 0), cA + kstep, voffA); PG8_STAGE(PG8_SB(1, 1), cB + hstep + kstep, voffB);
    PG8_WAIT_V(6); PG8_BAR;
    PG8_STAMP();
    for (;;) {
        const bool has_next = S.next(ui + 1, nxt);
        const char* nA = has_next ? (const char*)g.A + (size_t)nxt.pm * tstep : cA; const char* nB = has_next ? (const char*)g.Bt + (size_t)nxt.pn * tstep : cB;
        for (int t = 0; t < nt; t += 2) {
            const bool last = (t == nt - 2);
            const char* a1 = cA + (size_t)(t + 1) * kstep;
            const char* a2 = last ? nA : cA + (size_t)(t + 2) * kstep; const char* b2 = last ? nB : cB + (size_t)(t + 2) * kstep;
            const char* a3 = a2 + kstep; const char* b3 = b2 + kstep;
            if (last && has_next) S.a_ready(nxt);
            PG8_LDB(B0, 0, 0); PG8_SCHED; PG8_LDA(At, 0, 0); PG8_STAGE(PG8_SA(1, 1), a1 + hstep, voffA);
            PG8_WAIT_L(8); PG8_BAR; PG8_WAIT_L(0); PG8_MMA(0, 0, At, B0); PG8_BAR; PG8_SCHED;
            PG8_LDB(B1, 0, 1); PG8_STAGE(PG8_SB(0, 0), b2, voffB);
            PG8_BAR; PG8_WAIT_L(0); PG8_MMA(0, 1, At, B1); PG8_BAR;
            PG8_LDA(At, 0, 1); PG8_STAGE(PG8_SA(0, 0), a2, voffA);
            PG8_BAR; PG8_WAIT_L(0); PG8_MMA(1, 0, At, B0); PG8_BAR; PG8_SCHED;
            PG8_STAGE(PG8_SB(0, 1), b2 + hstep, voffB);
            PG8_WAIT_V(6); PG8_BAR; PG8_MMA(1, 1, At, B1); PG8_BAR;
            PG8_LDB(B0, 1, 0); PG8_SCHED; PG8_LDA(At, 1, 0); PG8_STAGE(PG8_SA(0, 1), a2 + hstep, voffA);
            PG8_WAIT_L(8); PG8_BAR; PG8_WAIT_L(0); PG8_MMA(0, 0, At, B0); PG8_BAR; PG8_SCHED;
            PG8_LDB(B1, 1, 1); PG8_STAGE(PG8_SB(1, 0), b3, voffB);
            PG8_BAR; PG8_WAIT_L(0); PG8_MMA(0, 1, At, B1); PG8_BAR;
            PG8_LDA(At, 1, 1); PG8_STAGE(PG8_SA(1, 0), a3, voffA);
            PG8_BAR; PG8_WAIT_L(0); PG8_MMA(1, 0, At, B0); PG8_BAR; PG8_SCHED;
            PG8_STAGE(PG8_SB(1, 1), b3 + hstep, voffB);
            PG8_WAIT_V(6); PG8_BAR; PG8_MMA(1, 1, At, B1); PG8_BAR;
        }
        PG8_STAMP();
        bool keep_acc = false;
        if constexpr (!Epi::AFTER_DRAIN) {
            if constexpr (Epi::CHAIN) { keep_acc = E.first(cur); if (keep_acc) E.mid(acc, cur, wr, wc, fr, fq); else E(acc, cur, wr, wc, fr, fq); }
            else E(acc, cur, wr, wc, fr, fq);
            S.done(cur); }
        PG8_STAMP();
        if (!has_next) break;
        if (!keep_acc)
#pragma unroll
        for (int a = 0; a < 2; ++a)
#pragma unroll
            for (int b = 0; b < 2; ++b)
#pragma unroll
                for (int m = 0; m < 4; ++m)
#pragma unroll
                    for (int n = 0; n < 2; ++n) acc[a][b][m][n] = (f32x4){0.f, 0.f, 0.f, 0.f};
        cur = nxt; cA = nA; cB = nB; ++ui;
    }
    PG8_WAIT_V(0);
    if (wr == 0) PG8_BAR;
    PG8_BAR;
    if constexpr (Epi::AFTER_DRAIN) { E.fused(acc, cur, wr, wc, fr, fq, lds, wid, lane); S.done(cur); }
    PG8_STAMP();
    if (STAMP && wid == 0) { stamps[lane] = lane < nts ? (((unsigned long long)(unsigned)ts_hi << 32) | (unsigned)ts_lo) : 0ull;
        if (lane == 62) stamps[62] = rt_entry; if (lane == 63) stamps[63] = (unsigned long long)wall_clock64(); }
#undef PG8_STAMP
#undef PG8_SA
#undef PG8_SB
#undef PG8_STAGE
#undef PG8_LDA
#undef PG8_LDB
#undef PG8_MMA
#undef PG8_WAIT_V
#undef PG8_WAIT_L
#undef PG8_BAR
#undef PG8_SCHED
}
}

#define DI __device__ __forceinline__
#define LAS __attribute__((address_space(3)))
typedef unsigned short bf16_t;
typedef short bf16x8 __attribute__((ext_vector_type(8)));
typedef float f32x4 __attribute__((ext_vector_type(4)));
typedef float f32x16 __attribute__((ext_vector_type(16)));
typedef unsigned u32x4 __attribute__((ext_vector_type(4)));
typedef unsigned u32x2 __attribute__((ext_vector_type(2)));
typedef __bf16 bf2_t __attribute__((ext_vector_type(2)));
typedef float f2_t __attribute__((ext_vector_type(2)));
typedef unsigned long long u64;

constexpr int TH = 8192, SEQ = 4096, DM = 2048, NP = 17664, DFF = 5632;
constexpr int C_KV = 2048, C_GQ = 5120, C_Z = 11264, C_MA = 13312, C_MB = 15360, C_GATE = 17408, C_A = 17456, C_B = 17472;
constexpr float EPS = 1e-6f;
constexpr float QSCALE = 0.08838834764831845f * 1.4426950408889634f;

constexpr size_t WS_WAT = 0, WS_WBT = 8388608, WS_WOT = 16777216, WS_WCT = 25165824, WS_CMPC = 563359744, WS_CTR = 27264000,
                 WS_KC = 27267072, WS_VCT = 27791360, WS_SEL = 28315648, WS_GEXP = 28577792, WS_X = 28585984,
                 WS_H = WS_X, WS_WINT = 491008000, WS_GQG = WS_X, WS_GKGT = WS_X + 33554432, WS_GW = WS_X + 67108864,
                 WS_PROJ = 134492160, WS_GU = 423899136, WS_GQK = 457453568, WS_VT = 474230784,
                 WS_XBAR = 563367936, WS_X1 = WS_X, WS_H2 = 162803712, WS_WGT = 229912576, WS_WDT = 276049920, WS_ACT = 299118592;
constexpr size_t DO_OA = 0, DO_OB = 33554432, DO_MIX = 67108864;

struct Params { const float* in[18]; float* out; unsigned char* ws; };

DI unsigned pk2(float a, float b) { f2_t v = {a, b}; return __builtin_bit_cast(unsigned, __builtin_convertvector(v, bf2_t)); }
DI float bflo(unsigned u) { return __uint_as_float(u << 16); }
DI float bfhi(unsigned u) { return __uint_as_float(u & 0xffff0000u); }
DI float bf2f(bf16_t h) { return __uint_as_float((unsigned)h << 16); }
DI bf16_t f2bf(float x) { return (bf16_t)(pk2(x, 0.f) & 0xffffu); }
template <int CTRL> DI float dppf(float v) { return __int_as_float(__builtin_amdgcn_update_dpp(0, __float_as_int(v), CTRL, 0xF, 0xF, true)); }
DI float sum8(float v) { v += dppf<0xB1>(v); v += dppf<0x4E>(v); v += dppf<0x141>(v); return v; }
DI float sum16(float v) { v = sum8(v); v += dppf<0x140>(v); return v; }
DI float wsum(float v) { v = sum16(v); v += __shfl_xor(v, 16); v += __shfl_xor(v, 32); return v; }
DI float sigm(float x) { return __builtin_amdgcn_rcpf(1.0f + __expf(-x)); }
DI float silu(float x) { return x * __builtin_amdgcn_rcpf(1.0f + __expf(-x)); }
DI f32x16 mfma32(bf16x8 a, bf16x8 b, f32x16 c) { return __builtin_amdgcn_mfma_f32_32x32x16_bf16(a, b, c, 0, 0, 0); }
DI f32x16 zero16() { f32x16 z; for (int i = 0; i < 16; ++i) z[i] = 0.f; return z; }
DI int crow(int reg, int h) { return (reg & 3) + 8 * (reg >> 2) + 4 * h; }
DI bf16x8 pack8(const f32x16& x, int s) { u32x4 p; p[0] = pk2(x[8 * s], x[8 * s + 1]); p[1] = pk2(x[8 * s + 2], x[8 * s + 3]); p[2] = pk2(x[8 * s + 4], x[8 * s + 5]); p[3] = pk2(x[8 * s + 6], x[8 * s + 7]); return __builtin_bit_cast(bf16x8, p); }
DI bf16x8 cat8(u32x2 a, u32x2 b) { u32x4 p = {a[0], a[1], b[0], b[1]}; return __builtin_bit_cast(bf16x8, p); }

template <int MAP> DI int map_row(int n) {
    if (MAP == 0) return n;
    if (MAP == 1) { if (n < 5120) return n; if (n < 5168) return 17408 + (n - 5120); if (n < 13360) return n - 48; if (n < 13376) return 17456 + (n - 13360); if (n < 13392) return 17472 + (n - 13376); return n - 80; }
    if (MAP == 2) return (n >> 7) * 256 + (n & 127);
    return (n >> 7) * 256 + 128 + (n & 127);
}
DI void xpose_ld(f32x4 (&v)[8], const float* src, int N, int kt, int nt, int tid) {
    const int k0 = kt * 64, n = nt * 256 + (tid & 63) * 4, r = tid >> 6;
#pragma unroll
    for (int i = 0; i < 8; ++i) { v[i] = (f32x4){0.f, 0.f, 0.f, 0.f}; if (n < N) v[i] = *(const f32x4*)(src + (size_t)(k0 + r + 8 * i) * N + n); }
}
template <int MAP> DI void xpose_put(LAS float* tile, const f32x4 (&v)[8], int K, int N, bf16_t* dst, int kt, int nt, int tid) {
    const int k0 = kt * 64, n0 = nt * 256, r = tid >> 6, c4 = (tid & 63) * 4;
#pragma unroll
    for (int i = 0; i < 8; ++i) { LAS float* d = tile + (r + 8 * i) * 257 + c4; d[0] = v[i][0]; d[1] = v[i][1]; d[2] = v[i][2]; d[3] = v[i][3]; }
    __syncthreads();
    const int kc = tid & 7;
#pragma unroll
    for (int ps = 0; ps < 4; ++ps) { const int nl = ps * 64 + (tid >> 3), n = n0 + nl;
        if (n < N) { u32x4 w;
#pragma unroll
            for (int j = 0; j < 4; ++j) w[j] = pk2(tile[(kc * 8 + 2 * j) * 257 + nl], tile[(kc * 8 + 2 * j + 1) * 257 + nl]);
            *(u32x4*)(dst + (size_t)map_row<MAP>(n) * K + k0 + kc * 8) = w; } }
    __syncthreads();
}
template <int MAP> DI void xpose_all(LAS float* tile, const float* src, int K, int N, bf16_t* dst, int tid, int bid, int G) {
    const int nkt = K / 64, nnt = (N + 255) / 256, tot = nkt * nnt;
    f32x4 va[8], vb[8];
    int i = bid;
    if (i < tot) xpose_ld(va, src, N, i / nnt, i % nnt, tid);
    for (; i < tot; i += 2 * G) {
        const int i1 = i + G, i2 = i + 2 * G;
        if (i1 < tot) xpose_ld(vb, src, N, i1 / nnt, i1 % nnt, tid);
        xpose_put<MAP>(tile, va, K, N, dst, i / nnt, i % nnt, tid);
        if (i1 < tot) {
            if (i2 < tot) xpose_ld(va, src, N, i2 / nnt, i2 % nnt, tid);
            xpose_put<MAP>(tile, vb, K, N, dst, i1 / nnt, i1 % nnt, tid);
        }
    }
}
DI void norm_rows(const float* x, const float* gain, bf16_t* out, int nrows, int tid, int bid, int G) {
    const int w = tid >> 6, lane = tid & 63;
    for (int row = bid * 8 + w; row < nrows; row += G * 8) {
        f32x4 v[8]; float ss = 0.f;
#pragma unroll
        for (int i = 0; i < 8; ++i) { v[i] = *(const f32x4*)(x + (size_t)row * DM + i * 256 + lane * 4); ss += v[i][0] * v[i][0] + v[i][1] * v[i][1] + v[i][2] * v[i][2] + v[i][3] * v[i][3]; }
        ss = wsum(ss); const float rs = rsqrtf(ss * (1.0f / DM) + EPS);
#pragma unroll
        for (int i = 0; i < 8; ++i) { const f32x4 gn = *(const f32x4*)(gain + i * 256 + lane * 4);
            u32x2 o; o[0] = pk2(v[i][0] * rs * gn[0], v[i][1] * rs * gn[1]); o[1] = pk2(v[i][2] * rs * gn[2], v[i][3] * rs * gn[3]);
            *(u32x2*)(out + (size_t)row * DM + i * 256 + lane * 4) = o; }
    }
}

struct EpiProj { static constexpr bool PERM = true, AFTER_DRAIN = false, CHAIN = false; bf16_t* O;
    DI void operator()(const pg8::f32x4 (&acc)[2][2][4][2], const pg8::Unit& u, int wr, int wc, int fr, int fq) const {
        const int row0 = u.pm * 256 + wr * 64 + fr, col0 = u.pn * 256 + wc * 32 + 8 * fq;
#pragma unroll
        for (int ai = 0; ai < 2; ++ai)
#pragma unroll
            for (int m = 0; m < 4; ++m) { bf16_t* rowp = O + (size_t)(row0 + ai * 128 + m * 16) * NP + col0;
#pragma unroll
                for (int bj = 0; bj < 2; ++bj) { const pg8::f32x4 v0 = acc[ai][bj][m][0], v1 = acc[ai][bj][m][1];
                    u32x4 w; w[0] = pk2(v0[0], v0[1]); w[1] = pk2(v0[2], v0[3]); w[2] = pk2(v1[0], v1[1]); w[3] = pk2(v1[2], v1[3]);
                    *(u32x4*)(rowp + bj * 128) = w; } }
    } };
template <bool ADD> struct EpiMix { static constexpr bool PERM = true, AFTER_DRAIN = false, CHAIN = false; bf16_t* MIX; const bf16_t* gate;
    DI void operator()(const pg8::f32x4 (&acc)[2][2][4][2], const pg8::Unit& u, int wr, int wc, int fr, int fq) const {
        const int row0 = u.pm * 256 + wr * 64 + fr, col0 = u.pn * 256 + wc * 32 + 8 * fq;
#pragma unroll
        for (int ai = 0; ai < 2; ++ai)
#pragma unroll
            for (int m = 0; m < 4; ++m) { const int row = row0 + ai * 128 + m * 16;
#pragma unroll
                for (int bj = 0; bj < 2; ++bj) { const pg8::f32x4 v0 = acc[ai][bj][m][0], v1 = acc[ai][bj][m][1];
                    const u32x4 gt = *(const u32x4*)(gate + (size_t)row * NP + col0 + bj * 128);
                    float o[8] = {v0[0], v0[1], v0[2], v0[3], v1[0], v1[1], v1[2], v1[3]};
#pragma unroll
                    for (int j = 0; j < 4; ++j) { o[2 * j] *= sigm(bflo(gt[j])); o[2 * j + 1] *= sigm(bfhi(gt[j])); }
                    bf16_t* dp = MIX + (size_t)row * DM + col0 + bj * 128;
                    if (ADD) { const u32x4 pr = *(const u32x4*)dp;
#pragma unroll
                        for (int j = 0; j < 4; ++j) { o[2 * j] += bflo(pr[j]); o[2 * j + 1] += bfhi(pr[j]); } }
                    u32x4 w; w[0] = pk2(o[0], o[1]); w[1] = pk2(o[2], o[3]); w[2] = pk2(o[4], o[5]); w[3] = pk2(o[6], o[7]);
                    *(u32x4*)dp = w; } }
    } };
struct EpiRes { static constexpr bool PERM = false, AFTER_DRAIN = false, CHAIN = false; float* C; const float* R;
    DI void operator()(const pg8::f32x4 (&acc)[2][2][4][2], const pg8::Unit& u, int wr, int wc, int fr, int fq) const {
        const int row0 = u.pm * 256 + wr * 64 + fr, col0 = u.pn * 256 + wc * 32 + 4 * fq;
#pragma unroll
        for (int ai = 0; ai < 2; ++ai)
#pragma unroll
            for (int m = 0; m < 4; ++m) { const size_t ro = (size_t)(row0 + ai * 128 + m * 16) * DM + col0;
#pragma unroll
                for (int bj = 0; bj < 2; ++bj)
#pragma unroll
                    for (int n = 0; n < 2; ++n) { const pg8::f32x4 rv = *(const pg8::f32x4*)(R + ro + bj * 128 + n * 16); *(pg8::f32x4*)(C + ro + bj * 128 + n * 16) = acc[ai][bj][m][n] + rv; } }
    } };
struct EpiGU { static constexpr bool PERM = true, AFTER_DRAIN = false, CHAIN = false; bf16_t* ACT;
    DI void operator()(const pg8::f32x4 (&acc)[2][2][4][2], const pg8::Unit& u, int wr, int wc, int fr, int fq) const {
        const int row0 = u.pm * 256 + wr * 64 + fr, col0 = u.pn * 128 + wc * 32 + 8 * fq;
#pragma unroll
        for (int ai = 0; ai < 2; ++ai)
#pragma unroll
            for (int m = 0; m < 4; ++m) { const pg8::f32x4 g0 = acc[ai][0][m][0], g1 = acc[ai][0][m][1], u0 = acc[ai][1][m][0], u1 = acc[ai][1][m][1];
                u32x4 w; w[0] = pk2(silu(g0[0]) * u0[0], silu(g0[1]) * u0[1]); w[1] = pk2(silu(g0[2]) * u0[2], silu(g0[3]) * u0[3]);
                w[2] = pk2(silu(g1[0]) * u1[0], silu(g1[1]) * u1[1]); w[3] = pk2(silu(g1[2]) * u1[2], silu(g1[3]) * u1[3]);
                *(u32x4*)(ACT + (size_t)(row0 + ai * 128 + m * 16) * DFF + col0) = w; }
    } };
struct BrOrder : pg8::StaticOrder {
    __device__ bool next(int i, pg8::Unit& u) const { if (!pg8::StaticOrder::next(i >> 1, u)) return false; if (i & 1) { u.pm += 32; u.pn += 8; } return true; }
};
struct EpiMix2 { static constexpr bool PERM = true, AFTER_DRAIN = false, CHAIN = true; bf16_t* MIX; const bf16_t* P;
    DI bool first(const pg8::Unit& u) const { return u.pm < 32; }
    DI void mid(pg8::f32x4 (&acc)[2][2][4][2], const pg8::Unit& u, int wr, int wc, int fr, int fq) const {
        const int row0 = u.pm * 256 + wr * 64 + fr, col0 = u.pn * 256 + wc * 32 + 8 * fq;
#pragma unroll
        for (int ai = 0; ai < 2; ++ai)
#pragma unroll
            for (int m = 0; m < 4; ++m) { const size_t ro = (size_t)(row0 + ai * 128 + m * 16) * NP + col0;
#pragma unroll
                for (int bj = 0; bj < 2; ++bj) { const u32x4 ga = *(const u32x4*)(P + ro + C_MA + bj * 128), gb = *(const u32x4*)(P + ro + C_MB + bj * 128);
#pragma unroll
                    for (int j = 0; j < 4; ++j) { const float r0 = (1.0f + __expf(-bflo(gb[j]))) * __builtin_amdgcn_rcpf(1.0f + __expf(-bflo(ga[j]))), r1 = (1.0f + __expf(-bfhi(gb[j]))) * __builtin_amdgcn_rcpf(1.0f + __expf(-bfhi(ga[j])));
                        acc[ai][bj][m][j >> 1][(j & 1) * 2] *= r0; acc[ai][bj][m][j >> 1][(j & 1) * 2 + 1] *= r1; } } }
    }
    DI void operator()(const pg8::f32x4 (&acc)[2][2][4][2], const pg8::Unit& u, int wr, int wc, int fr, int fq) const {
        const int row0 = (u.pm - 32) * 256 + wr * 64 + fr, col0 = (u.pn - 8) * 256 + wc * 32 + 8 * fq;
#pragma unroll
        for (int ai = 0; ai < 2; ++ai)
#pragma unroll
            for (int m = 0; m < 4; ++m) { const int row = row0 + ai * 128 + m * 16;
#pragma unroll
                for (int bj = 0; bj < 2; ++bj) { const pg8::f32x4 v0 = acc[ai][bj][m][0], v1 = acc[ai][bj][m][1];
                    const u32x4 gb = *(const u32x4*)(P + (size_t)row * NP + C_MB + col0 + bj * 128);
                    u32x4 w; w[0] = pk2(v0[0] * sigm(bflo(gb[0])), v0[1] * sigm(bfhi(gb[0]))); w[1] = pk2(v0[2] * sigm(bflo(gb[1])), v0[3] * sigm(bfhi(gb[1])));
                    w[2] = pk2(v1[0] * sigm(bflo(gb[2])), v1[1] * sigm(bfhi(gb[2]))); w[3] = pk2(v1[2] * sigm(bflo(gb[3])), v1[3] * sigm(bfhi(gb[3])));
                    *(u32x4*)(MIX + (size_t)row * DM + col0 + bj * 128) = w; } }
    } };
struct HalfOrder : pg8::StaticOrder {
    int n0;
    __device__ void init2(int M, int N, int G_, int c_) { pg8::StaticOrder::init(M / 2, N, G_, c_); n0 = c_ < nwg ? (nwg - c_ + G_ - 1) / G_ : 0; }
    __device__ bool next(int i, pg8::Unit& u) const { if (i >= 2 * n0) return false; const int h = i >= n0 ? 1 : 0; pg8::StaticOrder::next(i - h * n0, u); u.pm += h * nM; return true; }
};
template <class Epi> DI void run_gemm_half(LAS unsigned char* lds, const bf16_t* A, const bf16_t* Bt, int M, int N, int K, const Epi& E) {
    pg8::Gemm g{A, Bt, M, N, K}; HalfOrder S; S.init2(M, N, (int)gridDim.x, (int)blockIdx.x);
    pg8::gemm_phase<Epi, HalfOrder, false>((PG8_LAS unsigned char*)lds, g, S, E, nullptr);
    __syncthreads();
}
template <class Epi> DI void run_gemm(LAS unsigned char* lds, const bf16_t* A, const bf16_t* Bt, int M, int N, int K, const Epi& E) {
    pg8::Gemm g{A, Bt, M, N, K}; pg8::StaticOrder S; S.init(M, N, (int)gridDim.x, (int)blockIdx.x);
    pg8::gemm_phase<Epi, pg8::StaticOrder, false>((PG8_LAS unsigned char*)lds, g, S, E, nullptr);
    __syncthreads();
}

DI void qk_norm_item(bf16_t* PROJ, const float* qg, const float* kg, int item, int tid) {
    asm volatile("" : "+v"(tid));
    const int w = tid >> 6, lane = tid & 63, sub = lane & 15, vq = lane >> 4;
#pragma unroll 1
    for (int tt = 0; tt < 2; ++tt) {
        const int tok = item * 16 + w * 2 + tt;
#pragma unroll 1
        for (int it = 0; it < 6; ++it) {
            const int vi = it * 4 + vq;
            int col; const float* gn; float sc = 1.0f;
            if (vi < 16) { col = vi * 128; gn = qg; sc = QSCALE; }
            else if (vi < 20) { col = C_KV + (8 + (vi - 16)) * 128; gn = kg + 128; }
            else { col = C_KV + (16 + (vi - 20)) * 128; gn = kg + 256; }
            bf16_t* p = PROJ + (size_t)tok * NP + col + sub * 8;
            const u32x4 raw = *(const u32x4*)p; float v[8];
#pragma unroll
            for (int j = 0; j < 4; ++j) { v[2 * j] = bflo(raw[j]); v[2 * j + 1] = bfhi(raw[j]); }
            float ss = 0.f;
#pragma unroll
            for (int j = 0; j < 8; ++j) ss += v[j] * v[j];
            ss = sum16(ss);
            const float rs = rsqrtf(ss * (1.0f / 128.0f) + EPS) * sc;
            const f32x4 g0 = *(const f32x4*)(gn + sub * 8), g1 = *(const f32x4*)(gn + sub * 8 + 4);
            u32x4 o; o[0] = pk2(v[0] * rs * g0[0], v[1] * rs * g0[1]); o[1] = pk2(v[2] * rs * g0[2], v[3] * rs * g0[3]);
            o[2] = pk2(v[4] * rs * g1[0], v[5] * rs * g1[1]); o[3] = pk2(v[6] * rs * g1[2], v[7] * rs * g1[3]);
            *(u32x4*)p = o;
        }
    }
}
DI void cmp_item(LAS unsigned char* L, const bf16_t* PROJ, const bf16_t* WCT, const float* cmpc, const float* kgain, bf16_t* KC, bf16_t* VCT, int item, int tid) {
    asm volatile("" : "+v"(tid));
    const int rq = item & 3, kv = (item >> 2) & 1, g = (item >> 3) & 3, bl = item >> 5;
    const int w = tid >> 6, lane = tid & 63, c = lane & 31, hf = lane >> 5, mt = w & 1, et = w >> 1;
    int n = rq * 64 + mt * 32 + c; if (n > 254) n = 254;
    const bf16_t* ap = PROJ + (size_t)(bl * SEQ + 16 * n) * NP + C_KV + (kv * 4 + g) * 128 + hf * 8;
    const bf16_t* bp = WCT + (size_t)kv * 128 * 4096 + (size_t)(et * 32 + c) * 4096 + hf * 8;
    f32x16 acc = zero16();
#pragma unroll 1
    for (int l = 0; l < 32; ++l) {
#pragma unroll
        for (int ds = 0; ds < 8; ++ds) {
            const bf16x8 a = *(const bf16x8*)(ap + (size_t)l * NP + ds * 16);
            const bf16x8 b = *(const bf16x8*)(bp + l * 128 + ds * 16);
            acc = mfma32(a, b, acc);
        }
    }
    LAS float* st = (LAS float*)L;
    const int e = et * 32 + c; float cc = 0.f;
#pragma unroll
    for (int i = 0; i < 8; ++i) cc += cmpc[(kv * 8 + i) * 128 + e];
#pragma unroll
    for (int i = 0; i < 16; ++i) st[(mt * 32 + crow(i, hf)) * 129 + e] = acc[i] + cc;
    __syncthreads();
    if (kv == 0) {
#pragma unroll 1
        for (int rr = 0; rr < 8; ++rr) { const int row = w * 8 + rr, nn = rq * 64 + row;
            const float v0 = st[row * 129 + lane], v1 = st[row * 129 + lane + 64];
            const float ss = wsum(v0 * v0 + v1 * v1), rs = rsqrtf(ss * (1.0f / 128.0f) + EPS);
            bf16_t* d = KC + ((size_t)(bl * 256 + nn) * 4 + g) * 128;
            d[lane] = f2bf(v0 * rs * kgain[lane]); d[lane + 64] = f2bf(v1 * rs * kgain[lane + 64]); }
    } else {
        const int ee = tid >> 2, nc = (tid & 3) * 16; u32x4 o[2];
#pragma unroll
        for (int j = 0; j < 8; ++j) { const int r0 = nc + 2 * j; float a = st[r0 * 129 + ee], b = st[(r0 + 1) * 129 + ee];
            if (rq * 64 + r0 >= 255) a = 0.f; if (rq * 64 + r0 + 1 >= 255) b = 0.f; o[j >> 2][j & 3] = pk2(a, b); }
        bf16_t* d = VCT + ((size_t)(bl * 4 + g) * 128 + ee) * 256 + rq * 64 + nc;
        *(u32x4*)d = o[0]; *(u32x4*)(d + 8) = o[1];
    }
    __syncthreads();
}
DI void vt_item(LAS unsigned char* L, const bf16_t* PROJ, bf16_t* VT, int item, int tid) {
    asm volatile("" : "+v"(tid));
    const int tb = item & 63, g = (item >> 6) & 3, bl = (item >> 8) & 1, br = item >> 9;
    const bf16_t* src = PROJ + (size_t)(bl * SEQ + tb * 64) * NP + C_KV + (((br + 1) * 2 + 1) * 4 + g) * 128;
#pragma unroll
    for (int i = 0; i < 2; ++i) { const int c = tid + 512 * i, tok = c >> 4, part = c & 15;
        const u32x4 v = *(const u32x4*)(src + (size_t)tok * NP + part * 8);
        LAS u32x2* d = (LAS u32x2*)(L + tok * 264 + part * 16); d[0] = (u32x2){v[0], v[1]}; d[1] = (u32x2){v[2], v[3]}; }
    __syncthreads();
    const int d = tid >> 2, tc = (tid & 3) * 16; u32x4 o[2];
#pragma unroll
    for (int j = 0; j < 8; ++j) { const unsigned a = *(LAS bf16_t*)(L + (tc + 2 * j) * 264 + d * 2), b = *(LAS bf16_t*)(L + (tc + 2 * j + 1) * 264 + d * 2); o[j >> 2][j & 3] = a | (b << 16); }
    bf16_t* dst = VT + ((size_t)((br * 2 + bl) * 4 + g) * 128 + d) * SEQ + tb * 64 + tc;
    *(u32x4*)dst = o[0]; *(u32x4*)(dst + 8) = o[1];
    __syncthreads();
}
constexpr int GP_QB = 0, GP_KB = 17408, GP_KGT = 34816, GP_KBGT = 53248, GP_VBT = 71680, GP_LM = 90112, GP_TB = 107520, GP_QKS = 116736, GP_GC = 125952, GP_BETA = 126208;
DI void ld_lrows(unsigned addr, f32x4 (&lo)[8], f32x4 (&hi)[8]) {
    asm volatile("ds_read_b128 %0, %16\n\tds_read_b128 %8, %16 offset:16\n\tds_read_b128 %1, %16 offset:272\n\tds_read_b128 %9, %16 offset:288\n\t"
                 "ds_read_b128 %2, %16 offset:544\n\tds_read_b128 %10, %16 offset:560\n\tds_read_b128 %3, %16 offset:816\n\tds_read_b128 %11, %16 offset:832\n\t"
                 "ds_read_b128 %4, %16 offset:1088\n\tds_read_b128 %12, %16 offset:1104\n\tds_read_b128 %5, %16 offset:1360\n\tds_read_b128 %13, %16 offset:1376\n\t"
                 "ds_read_b128 %6, %16 offset:1632\n\tds_read_b128 %14, %16 offset:1648\n\tds_read_b128 %7, %16 offset:1904\n\tds_read_b128 %15, %16 offset:1920\n\t"
                 "s_waitcnt lgkmcnt(0)"
                 : "=&v"(lo[0]), "=&v"(lo[1]), "=&v"(lo[2]), "=&v"(lo[3]), "=&v"(lo[4]), "=&v"(lo[5]), "=&v"(lo[6]), "=&v"(lo[7]),
                   "=&v"(hi[0]), "=&v"(hi[1]), "=&v"(hi[2]), "=&v"(hi[3]), "=&v"(hi[4]), "=&v"(hi[5]), "=&v"(hi[6]), "=&v"(hi[7])
                 : "v"(addr) : "memory");
}
DI void gdn_prep_item(LAS unsigned char* L, const bf16_t* PROJ, const float* convw, const float* a_log, const float* dt_bias,
                      bf16_t* GQG, bf16_t* GKGT, bf16_t* GW, bf16_t* GUT, bf16_t* GQK, float* GEXP, int unit, int tid) {
    asm volatile("" : "+v"(tid));
    const int h = unit & 15, n = (unit >> 4) & 63, bl = unit >> 10;
    const int w = tid >> 6, lane = tid & 63, c = lane & 31, hf = lane >> 5;
    LAS float* gcs = (LAS float*)(L + GP_GC); LAS float* betas = (LAS float*)(L + GP_BETA);
    const bf16_t* base = PROJ + (size_t)(bl * SEQ) * NP;
    const int sl0 = n * 64 + w * 8;
    unsigned raw[3][11]; float cw[3][4][2];
#pragma unroll
        for (int wh = 0; wh < 3; ++wh) { const int col = C_GQ + wh * 2048 + h * 128 + 2 * lane;
#pragma unroll
            for (int r = 0; r < 11; ++r) { const int sl = sl0 - 3 + r; raw[wh][r] = (sl >= 0) ? *(const unsigned*)(base + (size_t)sl * NP + col) : 0u; }
#pragma unroll
            for (int i = 0; i < 4; ++i) { const f2_t cv = *(const f2_t*)(convw + (size_t)i * 6144 + wh * 2048 + h * 128 + 2 * lane); cw[wh][i][0] = cv[0]; cw[wh][i][1] = cv[1]; } }
    if (w == 0) {
        const size_t tok = (size_t)(n * 64 + lane);
        const float av = bf2f(base[tok * NP + C_A + h]), bv = bf2f(base[tok * NP + C_B + h]);
        const float xs = av + dt_bias[h]; const float sp = xs > 15.f ? xs : __logf(1.0f + __expf(xs));
        float gv = -__expf(a_log[h]) * sp;
#pragma unroll
        for (int o = 1; o < 64; o <<= 1) { const float t = __shfl_up(gv, o); if (lane >= o) gv += t; }
        gcs[lane] = gv; betas[lane] = sigm(bv);
    }
    __syncthreads();
    const float glast = gcs[63];
    {
        float pkg[2], pkbg[2], pvb[2];
#pragma unroll
        for (int tt = 0; tt < 8; ++tt) {
            float y[3][2];
#pragma unroll
            for (int wh = 0; wh < 3; ++wh) { float a0 = 0.f, a1 = 0.f;
#pragma unroll
                for (int i = 0; i < 4; ++i) { a0 += cw[wh][i][0] * bflo(raw[wh][tt + i]); a1 += cw[wh][i][1] * bfhi(raw[wh][tt + i]); }
                y[wh][0] = silu(a0); y[wh][1] = silu(a1); }
            const float ssq = wsum(y[0][0] * y[0][0] + y[0][1] * y[0][1]), ssk = wsum(y[1][0] * y[1][0] + y[1][1] * y[1][1]);
            const float qs = rsqrtf(ssq + EPS) * 0.08838834764831845f, ks = rsqrtf(ssk + EPS);
            const int t = w * 8 + tt; const float gct = gcs[t], bt = betas[t], eg = __expf(gct), ek = __expf(glast - gct);
            const float q0 = y[0][0] * qs, q1 = y[0][1] * qs, k0 = y[1][0] * ks, k1 = y[1][1] * ks;
            *(LAS unsigned*)(L + GP_QB + (t * 136 + 2 * lane) * 2) = pk2(q0, q1);
            *(LAS unsigned*)(L + GP_KB + (t * 136 + 2 * lane) * 2) = pk2(k0, k1);
            *(unsigned*)(GQG + (size_t)unit * 8192 + t * 128 + 2 * lane) = pk2(q0 * eg, q1 * eg);
            const float kg0 = k0 * ek, kg1 = k1 * ek, kb0 = k0 * bt * eg, kb1 = k1 * bt * eg, vb0 = y[2][0] * bt, vb1 = y[2][1] * bt;
            if (tt & 1) {
                *(LAS unsigned*)(L + GP_KGT + ((2 * lane) * 72 + t - 1) * 2) = pk2(pkg[0], kg0); *(LAS unsigned*)(L + GP_KGT + ((2 * lane + 1) * 72 + t - 1) * 2) = pk2(pkg[1], kg1);
                *(LAS unsigned*)(L + GP_KBGT + ((2 * lane) * 72 + t - 1) * 2) = pk2(pkbg[0], kb0); *(LAS unsigned*)(L + GP_KBGT + ((2 * lane + 1) * 72 + t - 1) * 2) = pk2(pkbg[1], kb1);
                *(LAS unsigned*)(L + GP_VBT + ((2 * lane) * 72 + t - 1) * 2) = pk2(pvb[0], vb0); *(LAS unsigned*)(L + GP_VBT + ((2 * lane + 1) * 72 + t - 1) * 2) = pk2(pvb[1], vb1);
            } else { pkg[0] = kg0; pkg[1] = kg1; pkbg[0] = kb0; pkbg[1] = kb1; pvb[0] = vb0; pvb[1] = vb1; }
        }
    }
    __syncthreads();
    {
        const int which = w >> 2, ti = (w >> 1) & 1, tj = w & 1;
        f32x16 acc = zero16();
        if (ti >= tj) {
#pragma unroll
            for (int s = 0; s < 8; ++s) {
                const bf16x8 a = *(const LAS bf16x8*)(L + (which ? GP_QB : GP_KB) + ((ti * 32 + c) * 136 + 16 * s + 8 * hf) * 2);
                const bf16x8 b = *(const LAS bf16x8*)(L + GP_KB + ((tj * 32 + c) * 136 + 16 * s + 8 * hf) * 2);
                acc = mfma32(a, b, acc);
            }
        }
        const int j = tj * 32 + c; const float gj = gcs[j];
#pragma unroll
        for (int r = 0; r < 16; ++r) { const int i = ti * 32 + crow(r, hf); const float gi = gcs[i];
            if (which == 0) { const float v = (i > j) ? betas[i] * acc[r] * __expf(gi - gj) : 0.f; *(LAS float*)(L + GP_LM + (i * 68 + (j & 7) * 8 + (j >> 3)) * 4) = v; }
            else { const float v = (i >= j) ? acc[r] * __expf(gi - gj) : 0.f; *(LAS bf16_t*)(L + GP_QKS + (i * 72 + j) * 2) = f2bf(v); } }
    }
    __syncthreads();
    {
        const int mp = lane & 7, j = 8 * w + (lane >> 3); float xr[8];
#pragma unroll
        for (int k = 0; k < 8; ++k) xr[k] = 0.f;
#pragma unroll
        for (int i8 = 0; i8 < 8; ++i8) {
            f32x4 lo[8], hi[8];
            ld_lrows((unsigned)(unsigned long)(L + GP_LM + ((8 * i8) * 68 + mp * 8) * 4), lo, hi);
#pragma unroll
            for (int r = 0; r < 8; ++r) { const int i = 8 * i8 + r; float a = 0.f;
#pragma unroll
                for (int k = 0; k < 8; ++k) if (8 * k < i) a += (k < 4 ? lo[r][k & 3] : hi[r][k & 3]) * xr[k];
                a = sum8(a);
                const float x = ((i == j) ? 1.f : 0.f) - a;
                if (mp == r) xr[i8] = x; }
        }
#pragma unroll
        for (int k = 0; k < 8; ++k) *(LAS bf16_t*)(L + GP_TB + ((8 * k + mp) * 72 + j) * 2) = f2bf(xr[k]);
    }
    __syncthreads();
    {
        const int mt = w & 1, dt = w >> 1; f32x16 au = zero16(), aw = zero16();
#pragma unroll
        for (int s = 0; s < 4; ++s) {
            const bf16x8 tb = *(const LAS bf16x8*)(L + GP_TB + ((mt * 32 + c) * 72 + 16 * s + 8 * hf) * 2);
            const bf16x8 vb = *(const LAS bf16x8*)(L + GP_VBT + ((dt * 32 + c) * 72 + 16 * s + 8 * hf) * 2);
            const bf16x8 kb = *(const LAS bf16x8*)(L + GP_KBGT + ((dt * 32 + c) * 72 + 16 * s + 8 * hf) * 2);
            au = mfma32(tb, vb, au); aw = mfma32(kb, tb, aw);
        }
#pragma unroll
        for (int q = 0; q < 4; ++q) {
            *(u32x2*)(GUT + (size_t)unit * 8192 + (dt * 32 + c) * 64 + mt * 32 + 8 * q + 4 * hf) = (u32x2){pk2(au[4 * q], au[4 * q + 1]), pk2(au[4 * q + 2], au[4 * q + 3])};
            *(u32x2*)(GW + (size_t)unit * 8192 + (mt * 32 + c) * 128 + dt * 32 + 8 * q + 4 * hf) = (u32x2){pk2(aw[4 * q], aw[4 * q + 1]), pk2(aw[4 * q + 2], aw[4 * q + 3])};
        }
#pragma unroll
        for (int i = 0; i < 2; ++i) { const int cc = tid + 512 * i, d = cc >> 3, part = cc & 7;
            *(u32x4*)(GKGT + (size_t)unit * 8192 + d * 64 + part * 8) = *(const LAS u32x4*)(L + GP_KGT + (d * 72 + part * 8) * 2); }
        { const int r = tid >> 3, part = tid & 7; *(u32x4*)(GQK + (size_t)unit * 4096 + r * 64 + part * 8) = *(const LAS u32x4*)(L + GP_QKS + (r * 72 + part * 8) * 2); }
        if (tid == 0) GEXP[unit] = __expf(glast);
    }
    __syncthreads();
}

DI void cmp_attn_item(LAS unsigned char* L, const bf16_t* PROJ, const bf16_t* KC, const bf16_t* VCT, bf16_t* OA, unsigned* SEL, const float* moff, int item, int tid) {
    asm volatile("" : "+v"(tid));
    const int qb = (item & 256) ? (item & 63) : 63 - (item & 63), g = (item >> 6) & 3, bl = (item >> 8) & 1 ? 1 : 0;
    const int w = tid >> 6, lane = tid & 63, c = lane & 31, hf = lane >> 5;
    const int tl = w * 8 + (c >> 2), r = c & 3, t = qb * 64 + tl, tok = bl * SEQ + t, h = g * 4 + r;
    bf16x8 qf[8];
#pragma unroll
    for (int s = 0; s < 8; ++s) qf[s] = *(const bf16x8*)(PROJ + (size_t)tok * NP + h * 128 + 16 * s + 8 * hf);
    const int ntile = (4 * qb + 34) >> 5, nvalid = t >= 31 ? ((t - 31) >> 4) + 1 : 0, lim = nvalid - 4 * hf;
    const bf16_t* kcb = KC + ((size_t)(bl * 256 + c) * 4 + g) * 128 + 8 * hf;
    const bf16_t* vcb = VCT + ((size_t)(bl * 4 + g) * 128 + c) * 256 + 4 * hf;
    const float m = moff[0];
    LAS float* Lv = (LAS float*)L + tid; float lsum = 0.f, Elast = 0.f; f32x16 O[4];
#pragma unroll
    for (int d = 0; d < 4; ++d) O[d] = zero16();
#pragma unroll
    for (int tau = 0; tau < 8; ++tau) {
        if (tau < ntile) {
            f32x16 acc = zero16();
#pragma unroll
            for (int s = 0; s < 8; ++s) acc = mfma32(*(const bf16x8*)(kcb + (size_t)tau * 32 * 512 + 16 * s), qf[s], acc);
#pragma unroll
            for (int i = 0; i < 16; ++i) { const float p = (32 * tau + crow(i, 0) < lim) ? __builtin_amdgcn_exp2f(acc[i] - m) : 0.f; acc[i] = p; lsum += p; }
#pragma unroll
            for (int a = 0; a < 4; ++a) { const float Wq = acc[4 * a] + acc[4 * a + 1] + acc[4 * a + 2] + 0.5f * acc[4 * a + 3], Eq = 0.5f * acc[4 * a + 3];
                const float ep_same = __shfl_xor(Eq, 32), ep_prev = __shfl_xor(Elast, 32);
                Lv[(tau * 4 + a) * 512] = Wq + (hf ? ep_same : ep_prev); Elast = Eq; }
#pragma unroll
            for (int s2 = 0; s2 < 2; ++s2) { const bf16x8 pf = pack8(acc, s2);
#pragma unroll
                for (int d = 0; d < 4; ++d) { const bf16_t* vp = vcb + (size_t)d * 32 * 256 + 32 * tau + 16 * s2;
                    O[d] = mfma32(cat8(*(const u32x2*)vp, *(const u32x2*)(vp + 8)), pf, O[d]); } }
        } else {
#pragma unroll
            for (int a = 0; a < 4; ++a) Lv[(tau * 4 + a) * 512] = 0.f;
        }
    }
    lsum += __shfl_xor(lsum, 32);
    const float inv = lsum > 0.f ? 1.0f / lsum : 0.f;
    {
        const float g0 = sigm(bf2f(PROJ[(size_t)tok * NP + C_GATE + h * 3 + 0])) * inv;
#pragma unroll
        for (int d = 0; d < 4; ++d)
#pragma unroll
            for (int q = 0; q < 4; ++q) *(u32x2*)(OA + (size_t)tok * DM + h * 128 + d * 32 + 8 * q + 4 * hf) = (u32x2){pk2(O[d][4 * q] * g0, O[d][4 * q + 1] * g0), pk2(O[d][4 * q + 2] * g0, O[d][4 * q + 3] * g0)};
    }
    LAS float* SC = (LAS float*)(L + 65536) + w * 520;
#pragma unroll
    for (int q = 0; q < 32; ++q) {
        float v = Lv[q * 512] * inv; v += dppf<0xB1>(v); v += dppf<0x4E>(v);
        const int j = 2 * q + hf; const bool forced = (j == 0) | (j == qb) | (j == qb - 1), causal = j <= qb;
        if (r == 0) SC[(c >> 2) * 65 + j] = forced ? 1e4f : (causal ? v : -1e4f);
    }
    asm volatile("s_waitcnt lgkmcnt(0)" ::: "memory");
    {
        const int tk = lane >> 3, jb = (lane & 7) * 8; float sv[8]; int cnt[8];
#pragma unroll
        for (int e = 0; e < 8; ++e) { sv[e] = SC[tk * 65 + jb + e]; cnt[e] = 0; }
#pragma unroll 4
        for (int j2 = 0; j2 < 64; ++j2) { const float v = SC[tk * 65 + j2];
#pragma unroll
            for (int e = 0; e < 8; ++e) cnt[e] += ((v > sv[e]) || (v == sv[e] && j2 < jb + e)) ? 1 : 0; }
        unsigned bits = 0u;
#pragma unroll
        for (int e = 0; e < 8; ++e) bits |= (cnt[e] < 16 && jb + e <= qb) ? (1u << e) : 0u;
        unsigned lo = (lane & 4) ? 0u : (bits << (jb & 31)), hi = (lane & 4) ? (bits << (jb & 31)) : 0u;
        lo |= __shfl_xor(lo, 1); hi |= __shfl_xor(hi, 1); lo |= __shfl_xor(lo, 2); hi |= __shfl_xor(hi, 2); lo |= __shfl_xor(lo, 4); hi |= __shfl_xor(hi, 4);
        if ((lane & 7) == 0) *(u32x2*)(SEL + ((size_t)(bl * SEQ + qb * 64 + w * 8 + tk) * 4 + g) * 2) = (u32x2){lo, hi};
    }
    asm volatile("s_waitcnt lgkmcnt(0)" ::: "memory");
}

constexpr int AT_K = 0, AT_V = 34816, AT_MISC = 71680;
DI void at_load(const bf16_t* Kg, const bf16_t* VTg, int j, int tid, u32x4 (&kr)[2], u32x4 (&vr)[2]) {
    const char* kb = (const char*)(Kg + (size_t)j * 64 * NP); const char* vb = (const char*)(VTg + j * 64);
#pragma unroll
    for (int i = 0; i < 2; ++i) { const int cc = tid + 512 * i; unsigned ko = (unsigned)(((cc >> 4) * NP + (cc & 15) * 8) * 2), vo = (unsigned)(((cc >> 3) * SEQ + (cc & 7) * 8) * 2);
        asm volatile("" : "+v"(ko), "+v"(vo));
        kr[i] = *(const u32x4*)(kb + ko); vr[i] = *(const u32x4*)(vb + vo); }
}
DI void at_store(LAS unsigned char* L, int buf, int tid, const u32x4 (&kr)[2], const u32x4 (&vr)[2]) {
#pragma unroll
    for (int i = 0; i < 2; ++i) { const int cc = tid + 512 * i, part = cc & 7;
        *(LAS u32x4*)(L + AT_K + buf * 17408 + (cc >> 4) * 272 + (cc & 15) * 16) = kr[i];
        LAS unsigned char* d = L + AT_V + buf * 18432 + (cc >> 3) * 144 + (part >> 1) * 32 + (part & 1) * 8;
        *(LAS u32x2*)d = (u32x2){vr[i][0], vr[i][1]}; *(LAS u32x2*)(d + 16) = (u32x2){vr[i][2], vr[i][3]}; }
}
DI int at_next(int j, int qb, u64 um) { for (++j; j <= qb; ++j) if ((um >> j) & 1ull) break; return j; }
DI void qk_chain(f32x16& sc, unsigned addr, const bf16x8 (&q)[8]) {
    bf16x8 k0, k1, k2, k3, k4, k5, k6, k7;
    asm volatile(
        "ds_read_b128 %1, %9\n\tds_read_b128 %2, %9 offset:32\n\tds_read_b128 %3, %9 offset:64\n\tds_read_b128 %4, %9 offset:96\n\t"
        "ds_read_b128 %5, %9 offset:128\n\tds_read_b128 %6, %9 offset:160\n\tds_read_b128 %7, %9 offset:192\n\tds_read_b128 %8, %9 offset:224\n\t"
        "s_waitcnt lgkmcnt(7)\n\tv_mfma_f32_32x32x16_bf16 %0, %1, %10, %0\n\t"
        "s_waitcnt lgkmcnt(6)\n\tv_mfma_f32_32x32x16_bf16 %0, %2, %11, %0\n\t"
        "s_waitcnt lgkmcnt(5)\n\tv_mfma_f32_32x32x16_bf16 %0, %3, %12, %0\n\t"
        "s_waitcnt lgkmcnt(4)\n\tv_mfma_f32_32x32x16_bf16 %0, %4, %13, %0\n\t"
        "s_waitcnt lgkmcnt(3)\n\tv_mfma_f32_32x32x16_bf16 %0, %5, %14, %0\n\t"
        "s_waitcnt lgkmcnt(2)\n\tv_mfma_f32_32x32x16_bf16 %0, %6, %15, %0\n\t"
        "s_waitcnt lgkmcnt(1)\n\tv_mfma_f32_32x32x16_bf16 %0, %7, %16, %0\n\t"
        "s_waitcnt lgkmcnt(0)\n\tv_mfma_f32_32x32x16_bf16 %0, %8, %17, %0\n\t"
        "s_nop 15\n\ts_nop 3"
        : "+v"(sc), "=&v"(k0), "=&v"(k1), "=&v"(k2), "=&v"(k3), "=&v"(k4), "=&v"(k5), "=&v"(k6), "=&v"(k7)
        : "v"(addr), "v"(q[0]), "v"(q[1]), "v"(q[2]), "v"(q[3]), "v"(q[4]), "v"(q[5]), "v"(q[6]), "v"(q[7])
        : "memory");
}
DI void pv_chain(f32x16& o0, f32x16& o1, f32x16& o2, f32x16& o3, unsigned addr, bf16x8 p0, bf16x8 p1) {
    bf16x8 v0, v1, v2, v3, v4, v5, v6, v7;
    asm volatile(
        "ds_read_b128 %4, %12\n\tds_read_b128 %5, %12 offset:4608\n\tds_read_b128 %6, %12 offset:9216\n\tds_read_b128 %7, %12 offset:13824\n\t"
        "ds_read_b128 %8, %12 offset:32\n\tds_read_b128 %9, %12 offset:4640\n\tds_read_b128 %10, %12 offset:9248\n\tds_read_b128 %11, %12 offset:13856\n\t"
        "s_waitcnt lgkmcnt(7)\n\tv_mfma_f32_32x32x16_bf16 %0, %4, %13, %0\n\t"
        "s_waitcnt lgkmcnt(6)\n\tv_mfma_f32_32x32x16_bf16 %1, %5, %13, %1\n\t"
        "s_waitcnt lgkmcnt(5)\n\tv_mfma_f32_32x32x16_bf16 %2, %6, %13, %2\n\t"
        "s_waitcnt lgkmcnt(4)\n\tv_mfma_f32_32x32x16_bf16 %3, %7, %13, %3\n\t"
        "s_waitcnt lgkmcnt(3)\n\tv_mfma_f32_32x32x16_bf16 %0, %8, %14, %0\n\t"
        "s_waitcnt lgkmcnt(2)\n\tv_mfma_f32_32x32x16_bf16 %1, %9, %14, %1\n\t"
        "s_waitcnt lgkmcnt(1)\n\tv_mfma_f32_32x32x16_bf16 %2, %10, %14, %2\n\t"
        "s_waitcnt lgkmcnt(0)\n\tv_mfma_f32_32x32x16_bf16 %3, %11, %14, %3\n\t"
        "s_nop 15\n\ts_nop 3"
        : "+v"(o0), "+v"(o1), "+v"(o2), "+v"(o3), "=&v"(v0), "=&v"(v1), "=&v"(v2), "=&v"(v3), "=&v"(v4), "=&v"(v5), "=&v"(v6), "=&v"(v7)
        : "v"(addr), "v"(p0), "v"(p1)
        : "memory");
}
template <int MODE> DI void attn_pass(LAS unsigned char* L, const bf16_t* Kg, const bf16_t* VTg, int qb, u64 selm, u64 um, int tl64, const bf16x8 (&qf)[8],
                                      f32x16 (&O)[4], float& lsum, float moff, int tid) {
    const int lane = tid & 63, c = lane & 31, hf = lane >> 5;
    lsum = 0.f;
#pragma unroll
    for (int d = 0; d < 4; ++d) O[d] = zero16();
    int j = at_next((MODE ? (qb > 8 ? qb - 8 : 0) : 0) - 1, qb, um), buf = 0;
    u32x4 kr[2], vr[2];
    if (j <= qb) { at_load(Kg, VTg, j, tid, kr, vr); at_store(L, 0, tid, kr, vr); }
    __syncthreads();
    while (j <= qb) {
        const int jn = at_next(j, qb, um);
        if (jn <= qb) at_load(Kg, VTg, jn, tid, kr, vr);
        {
            const LAS unsigned char* Kt = L + AT_K + buf * 17408; const LAS unsigned char* Vt = L + AT_V + buf * 18432;
            const bool diag = (j == qb), first = MODE ? (j == qb - 8) : false, selb = MODE ? true : (((selm >> j) & 1ull) != 0ull);
            const float init = selb ? -moff : -__builtin_inff();
            const int tlh = tl64 - 4 * hf;
            float ps = 0.f; bf16x8 pk[2][2];
#pragma unroll
            for (int kt = 0; kt < 2; ++kt) {
                f32x16 sc;
#pragma unroll
                for (int i = 0; i < 16; ++i) sc[i] = init;
                qk_chain(sc, (unsigned)(unsigned long)(Kt + (kt * 32 + c) * 272 + hf * 16), qf);
                if (diag || first) {
#pragma unroll
                    for (int i = 0; i < 16; ++i) { const int k0 = kt * 32 + crow(i, 0); sc[i] = (diag ? (k0 <= tlh) : (k0 > tlh)) ? sc[i] : -__builtin_inff(); }
                }
#pragma unroll
                for (int i = 0; i < 16; ++i) { const float p = __builtin_amdgcn_exp2f(sc[i]); sc[i] = p; ps += p; }
                pk[kt][0] = pack8(sc, 0); pk[kt][1] = pack8(sc, 1);
            }
            lsum += ps;
#pragma unroll
            for (int kt = 0; kt < 2; ++kt)
                pv_chain(O[0], O[1], O[2], O[3], (unsigned)(unsigned long)(Vt + c * 144 + kt * 64 + hf * 16), pk[kt][0], pk[kt][1]);
        }
        if (jn <= qb) at_store(L, buf ^ 1, tid, kr, vr);
        __syncthreads();
        buf ^= 1; j = jn;
    }
    lsum += __shfl_xor(lsum, 32);
}
DI void attn_item(LAS unsigned char* L, const bf16_t* PROJ, const bf16_t* VT, const unsigned* SEL, bf16_t* OA, const float* moff, int item, int tid) {
    asm volatile("" : "+v"(tid));
    const int qb = 63 - (item >> 3), g = item & 3, bl = (item >> 2) & 1;
    const int w = tid >> 6, lane = tid & 63, c = lane & 31, hf = lane >> 5;
    const int tl64 = w * 8 + (c >> 2), r = c & 3, tok = bl * SEQ + qb * 64 + tl64, h = g * 4 + r;
    bf16x8 qf[8];
#pragma unroll
    for (int s = 0; s < 8; ++s) qf[s] = *(const bf16x8*)(PROJ + (size_t)tok * NP + h * 128 + 16 * s + 8 * hf);
    const u32x2 sm = *(const u32x2*)(SEL + ((size_t)tok * 4 + g) * 2);
    const u64 selm = (u64)sm[0] | ((u64)sm[1] << 32);
    unsigned ulo = sm[0], uhi = sm[1];
#pragma unroll
    for (int o = 1; o < 64; o <<= 1) { ulo |= __shfl_xor(ulo, o); uhi |= __shfl_xor(uhi, o); }
    LAS unsigned* misc = (LAS unsigned*)(L + AT_MISC);
    if (lane == 0) { misc[2 * w] = ulo; misc[2 * w + 1] = uhi; }
    __syncthreads();
    unsigned alo = 0u, ahi = 0u;
#pragma unroll
    for (int i = 0; i < 8; ++i) { alo |= misc[2 * i]; ahi |= misc[2 * i + 1]; }
    const u64 um = (u64)alo | ((u64)ahi << 32);
    const float g1 = sigm(bf2f(PROJ[(size_t)tok * NP + C_GATE + h * 3 + 1])), g2 = sigm(bf2f(PROJ[(size_t)tok * NP + C_GATE + h * 3 + 2]));
    f32x16 O[4]; float lsum;
    const bf16_t* pb = PROJ + (size_t)(bl * SEQ) * NP;
#pragma unroll 1
    for (int pass = 0; pass < 2; ++pass) {
        if (pass == 0) attn_pass<0>(L, pb + C_KV + (8 + g) * 128, VT + (size_t)((0 * 2 + bl) * 4 + g) * 128 * SEQ, qb, selm, um, tl64, qf, O, lsum, moff[1], tid);
        else attn_pass<1>(L, pb + C_KV + (16 + g) * 128, VT + (size_t)((1 * 2 + bl) * 4 + g) * 128 * SEQ, qb, ~0ull, ~0ull, tl64, qf, O, lsum, moff[2], tid);
        const float f = lsum > 0.f ? (pass ? g2 : g1) / lsum : 0.f;
#pragma unroll
        for (int d = 0; d < 4; ++d)
#pragma unroll
            for (int q = 0; q < 4; ++q) { bf16_t* op = OA + (size_t)tok * DM + h * 128 + d * 32 + 8 * q + 4 * hf; const u32x2 pr = *(const u32x2*)op;
                const float a0 = bflo(pr[0]) + O[d][4 * q] * f, a1 = bfhi(pr[0]) + O[d][4 * q + 1] * f, a2 = bflo(pr[1]) + O[d][4 * q + 2] * f, a3 = bfhi(pr[1]) + O[d][4 * q + 3] * f;
                *(u32x2*)op = (u32x2){pk2(a0, a1), pk2(a2, a3)}; }
    }
}

struct ScanFrag { u32x2 wf[2][2][2], qg[2][2][2], qk[2][2], kg[4][2], u[2][4]; float eg; };
DI void scan_load(ScanFrag& F, const bf16_t* GQG, const bf16_t* GKGT, const bf16_t* GW, const bf16_t* GUT, const bf16_t* GQK, const float* GEXP, size_t unit, int sl, int ww, int c, int hf) {
#pragma unroll
    for (int mt = 0; mt < 2; ++mt) {
#pragma unroll
        for (int s = 0; s < 2; ++s) { const size_t o = unit * 8192 + (size_t)(mt * 32 + c) * 128 + 32 * ww + 16 * s + 4 * hf;
            F.wf[mt][s][0] = *(const u32x2*)(GW + o); F.wf[mt][s][1] = *(const u32x2*)(GW + o + 8); F.qg[mt][s][0] = *(const u32x2*)(GQG + o); F.qg[mt][s][1] = *(const u32x2*)(GQG + o + 8); }
        { const size_t o = unit * 4096 + (size_t)(mt * 32 + c) * 64 + 16 * ww + 4 * hf; F.qk[mt][0] = *(const u32x2*)(GQK + o); F.qk[mt][1] = *(const u32x2*)(GQK + o + 8); }
#pragma unroll
        for (int q = 0; q < 4; ++q) F.u[mt][q] = *(const u32x2*)(GUT + unit * 8192 + (size_t)(sl * 32 + c) * 64 + mt * 32 + 8 * q + 4 * hf);
    }
#pragma unroll
    for (int s = 0; s < 4; ++s) { const size_t o = unit * 8192 + (size_t)(32 * ww + c) * 64 + 16 * s + 4 * hf; F.kg[s][0] = *(const u32x2*)(GKGT + o); F.kg[s][1] = *(const u32x2*)(GKGT + o + 8); }
    F.eg = GEXP[unit];
}
DI void scan_step(const ScanFrag& F, f32x16& st, LAS float* P1, LAS float* OB, bf16_t* GUT, size_t unit, int sl, int ww, int lane, int tl, bool active) {
    bf16x8 sf[2]; sf[0] = pack8(st, 0); sf[1] = pack8(st, 1);
    if (active) {
#pragma unroll
    for (int mt = 0; mt < 2; ++mt) { f32x16 p = zero16(); p = mfma32(cat8(F.wf[mt][0][0], F.wf[mt][0][1]), sf[0], p); p = mfma32(cat8(F.wf[mt][1][0], F.wf[mt][1][1]), sf[1], p);
#pragma unroll
        for (int i = 0; i < 16; ++i) P1[((ww * 2 + mt) * 16 + i) * 64 + lane] = p[i]; }
    }
    __syncthreads();
    if (active) {
    f32x16 u[2]; bf16x8 vf[2][2];
#pragma unroll
    for (int mt = 0; mt < 2; ++mt) {
#pragma unroll
        for (int q = 0; q < 4; ++q) { u[mt][4 * q] = bflo(F.u[mt][q][0]); u[mt][4 * q + 1] = bfhi(F.u[mt][q][0]); u[mt][4 * q + 2] = bflo(F.u[mt][q][1]); u[mt][4 * q + 3] = bfhi(F.u[mt][q][1]); }
#pragma unroll
        for (int i = 0; i < 16; ++i) { float sm = 0.f;
#pragma unroll
            for (int w2 = 0; w2 < 4; ++w2) sm += P1[((w2 * 2 + mt) * 16 + i) * 64 + lane];
            u[mt][i] -= sm; }
        vf[mt][0] = pack8(u[mt], 0); vf[mt][1] = pack8(u[mt], 1);
    }
    const bf16x8 vsel = (ww == 0) ? vf[0][0] : (ww == 1) ? vf[0][1] : (ww == 2) ? vf[1][0] : vf[1][1];
#pragma unroll
    for (int mt = 0; mt < 2; ++mt) { f32x16 o = zero16(); o = mfma32(cat8(F.qg[mt][0][0], F.qg[mt][0][1]), sf[0], o); o = mfma32(cat8(F.qg[mt][1][0], F.qg[mt][1][1]), sf[1], o); o = mfma32(cat8(F.qk[mt][0], F.qk[mt][1]), vsel, o);
#pragma unroll
        for (int i = 0; i < 16; ++i) OB[((ww * 2 + mt) * 16 + i) * 64 + lane] = o[i]; }
#pragma unroll
    for (int i = 0; i < 16; ++i) st[i] *= F.eg;
#pragma unroll
    for (int s = 0; s < 4; ++s) st = mfma32(cat8(F.kg[s][0], F.kg[s][1]), vf[s >> 1][s & 1], st);
    }
    __syncthreads();
    if (active) {
    const int l2 = tl & 63, q = tl >> 6;
#pragma unroll
    for (int mt = 0; mt < 2; ++mt) { float o4[4];
#pragma unroll
        for (int e = 0; e < 4; ++e) { float sm = 0.f;
#pragma unroll
            for (int w2 = 0; w2 < 4; ++w2) sm += OB[((w2 * 2 + mt) * 16 + 4 * q + e) * 64 + l2];
            o4[e] = sm; }
        *(u32x2*)(GUT + unit * 8192 + (size_t)(sl * 32 + (l2 & 31)) * 64 + mt * 32 + 8 * q + 4 * (l2 >> 5)) = (u32x2){pk2(o4[0], o4[1]), pk2(o4[2], o4[3])}; }
    }
}
DI void gdn_scan(LAS unsigned char* L, const bf16_t* GQG, const bf16_t* GKGT, const bf16_t* GW, bf16_t* GUT, const bf16_t* GQK, const float* GEXP, int su, int tid) {
    const int w = tid >> 6, lane = tid & 63, c = lane & 31, hf = lane >> 5, ww = w & 3, tl = tid & 255;
    const bool active = w < 4;
    const int sl = su & 3, h = (su >> 2) & 15, bl = su >> 6;
    LAS float* P1 = (LAS float*)L; LAS float* OB = (LAS float*)(L + 32768);
    f32x16 st = zero16();
    ScanFrag A, B;
    if (active) scan_load(A, GQG, GKGT, GW, GUT, GQK, GEXP, (size_t)((bl * 64 + 0) * 16 + h), sl, ww, c, hf);
#pragma unroll 1
    for (int n = 0; n < 64; n += 2) {
        const size_t u0 = (size_t)((bl * 64 + n) * 16 + h), u1 = u0 + 16, u2 = u0 + 32;
        if (active) scan_load(B, GQG, GKGT, GW, GUT, GQK, GEXP, u1, sl, ww, c, hf);
        scan_step(A, st, P1, OB, GUT, u0, sl, ww, lane, tl, active);
        if (active && n + 2 < 64) scan_load(A, GQG, GKGT, GW, GUT, GQK, GEXP, u2, sl, ww, c, hf);
        scan_step(B, st, P1, OB, GUT, u1, sl, ww, lane, tl, active);
    }
    __syncthreads();
}
constexpr int SC_W = 0, SC_QG = 17408, SC_KG = 34816, SC_QK = 53248, SC_BUF = 62464;
DI void scan2_ld(u32x4 (&r)[14], const bf16_t* GQG, const bf16_t* GKGT, const bf16_t* GW, const bf16_t* GQK, size_t unit, int lt) {
#pragma unroll
    for (int i = 0; i < 4; ++i) { const int cc = lt + 256 * i; r[i] = *(const u32x4*)(GW + unit * 8192 + cc * 8); r[4 + i] = *(const u32x4*)(GQG + unit * 8192 + cc * 8); r[8 + i] = *(const u32x4*)(GKGT + unit * 8192 + cc * 8); }
#pragma unroll
    for (int i = 0; i < 2; ++i) { const int cc = lt + 256 * i; r[12 + i] = *(const u32x4*)(GQK + unit * 4096 + cc * 8); }
}
DI void scan2_put(LAS unsigned char* d, const u32x4& v) { *(LAS u32x2*)d = (u32x2){v[0], v[1]}; *(LAS u32x2*)(d + 16) = (u32x2){v[2], v[3]}; }
DI void scan2_st(LAS unsigned char* B, const u32x4 (&r)[14], int lt) {
#pragma unroll
    for (int i = 0; i < 4; ++i) { const int cc = lt + 256 * i;
        { const int row = cc >> 4, part = cc & 15, o = row * 272 + (part >> 1) * 32 + (part & 1) * 8; scan2_put(B + SC_W + o, r[i]); scan2_put(B + SC_QG + o, r[4 + i]); }
        { const int row = cc >> 3, part = cc & 7; scan2_put(B + SC_KG + row * 144 + (part >> 1) * 32 + (part & 1) * 8, r[8 + i]); } }
#pragma unroll
    for (int i = 0; i < 2; ++i) { const int cc = lt + 256 * i, row = cc >> 3, part = cc & 7; scan2_put(B + SC_QK + row * 144 + (part >> 1) * 32 + (part & 1) * 8, r[12 + i]); }
}
DI void gdn_scan2(LAS unsigned char* L, const bf16_t* GQG, const bf16_t* GKGT, const bf16_t* GW, bf16_t* GUT, const bf16_t* GQK, const float* GEXP, int su, int tid) {
    const int w = tid >> 6, lane = tid & 63, c = lane & 31, hf = lane >> 5, h = su & 15, bl = su >> 4;
#define SC_UNIT(n) ((size_t)((bl * 64 + (n)) * 16 + h))
    if (w >= 4) {
        const int lt = tid - 256; u32x4 r[14];
        scan2_ld(r, GQG, GKGT, GW, GQK, SC_UNIT(0), lt); scan2_st(L, r, lt);
        scan2_ld(r, GQG, GKGT, GW, GQK, SC_UNIT(1), lt);
        __syncthreads();
#pragma unroll 1
        for (int n = 0; n < 64; ++n) {
            if (n + 1 < 64) scan2_st(L + ((n + 1) & 1) * SC_BUF, r, lt);
            if (n + 2 < 64) scan2_ld(r, GQG, GKGT, GW, GQK, SC_UNIT(n + 2), lt);
            __syncthreads();
        }
    } else {
        const int sl = w; f32x16 st[4]; u32x2 un[2][4]; float egn;
#pragma unroll
        for (int t = 0; t < 4; ++t) st[t] = zero16();
#pragma unroll
        for (int mt = 0; mt < 2; ++mt)
#pragma unroll
            for (int q = 0; q < 4; ++q) un[mt][q] = *(const u32x2*)(GUT + SC_UNIT(0) * 8192 + (size_t)(sl * 32 + c) * 64 + mt * 32 + 8 * q + 4 * hf);
        egn = GEXP[SC_UNIT(0)];
        __syncthreads();
#pragma unroll 1
        for (int n = 0; n < 64; ++n) {
            const LAS unsigned char* B = L + (n & 1) * SC_BUF; const size_t unit = SC_UNIT(n);
            f32x16 vn[2]; const float eg = egn;
#pragma unroll
            for (int mt = 0; mt < 2; ++mt)
#pragma unroll
                for (int q = 0; q < 4; ++q) { vn[mt][4 * q] = bflo(un[mt][q][0]); vn[mt][4 * q + 1] = bfhi(un[mt][q][0]); vn[mt][4 * q + 2] = bflo(un[mt][q][1]); vn[mt][4 * q + 3] = bfhi(un[mt][q][1]); }
            if (n + 1 < 64) {
#pragma unroll
                for (int mt = 0; mt < 2; ++mt)
#pragma unroll
                    for (int q = 0; q < 4; ++q) un[mt][q] = *(const u32x2*)(GUT + SC_UNIT(n + 1) * 8192 + (size_t)(sl * 32 + c) * 64 + mt * 32 + 8 * q + 4 * hf);
                egn = GEXP[SC_UNIT(n + 1)];
            }
            bf16x8 sf[4][2];
#pragma unroll
            for (int t = 0; t < 4; ++t) { sf[t][0] = pack8(st[t], 0); sf[t][1] = pack8(st[t], 1); }
#pragma unroll
            for (int mt = 0; mt < 2; ++mt) { f32x16 p = zero16();
#pragma unroll
                for (int t = 0; t < 4; ++t)
#pragma unroll
                    for (int s = 0; s < 2; ++s) p = mfma32(*(const LAS bf16x8*)(B + SC_W + (mt * 32 + c) * 272 + (2 * t + s) * 32 + hf * 16), sf[t][s], p);
#pragma unroll
                for (int i = 0; i < 16; ++i) vn[mt][i] -= p[i]; }
            bf16x8 vf[2][2];
#pragma unroll
            for (int mt = 0; mt < 2; ++mt) { vf[mt][0] = pack8(vn[mt], 0); vf[mt][1] = pack8(vn[mt], 1); }
#pragma unroll
            for (int mt = 0; mt < 2; ++mt) { f32x16 o = zero16();
#pragma unroll
                for (int t = 0; t < 4; ++t)
#pragma unroll
                    for (int s = 0; s < 2; ++s) o = mfma32(*(const LAS bf16x8*)(B + SC_QG + (mt * 32 + c) * 272 + (2 * t + s) * 32 + hf * 16), sf[t][s], o);
#pragma unroll
                for (int j = 0; j < 4; ++j) o = mfma32(*(const LAS bf16x8*)(B + SC_QK + (mt * 32 + c) * 144 + j * 32 + hf * 16), vf[j >> 1][j & 1], o);
#pragma unroll
                for (int q = 0; q < 4; ++q) *(u32x2*)(GUT + unit * 8192 + (size_t)(sl * 32 + c) * 64 + mt * 32 + 8 * q + 4 * hf) = (u32x2){pk2(o[4 * q], o[4 * q + 1]), pk2(o[4 * q + 2], o[4 * q + 3])}; }
#pragma unroll
            for (int t = 0; t < 4; ++t) {
#pragma unroll
                for (int i = 0; i < 16; ++i) st[t][i] *= eg;
#pragma unroll
                for (int j = 0; j < 4; ++j) st[t] = mfma32(*(const LAS bf16x8*)(B + SC_KG + (32 * t + c) * 144 + j * 32 + hf * 16), vf[j >> 1][j & 1], st[t]); }
            __syncthreads();
        }
    }
#undef SC_UNIT
    __syncthreads();
}
DI void obnorm_item(LAS unsigned char* L, const bf16_t* GUT, const bf16_t* PROJ, const float* ogain, bf16_t* OBm, int unit, int tid) {
    const int h = unit & 15, n = (unit >> 4) & 63, bl = unit >> 10;
#pragma unroll
    for (int i = 0; i < 2; ++i) { const int cc = tid + 512 * i, d = cc >> 3, part = cc & 7; const u32x4 v = *(const u32x4*)(GUT + (size_t)unit * 8192 + d * 64 + part * 8);
        LAS unsigned* dp = (LAS unsigned*)(L + d * 132 + part * 16); dp[0] = v[0]; dp[1] = v[1]; dp[2] = v[2]; dp[3] = v[3]; }
    __syncthreads();
#pragma unroll
    for (int i = 0; i < 2; ++i) {
        const int wi = tid + 512 * i, t = wi >> 4, dvg = wi & 15; const size_t tok = (size_t)(bl * SEQ + n * 64 + t);
        const u32x4 zr = *(const u32x4*)(PROJ + tok * NP + C_Z + h * 128 + dvg * 8);
        const f32x4 ga = *(const f32x4*)(ogain + dvg * 8), gb = *(const f32x4*)(ogain + dvg * 8 + 4);
        float v[8], ss = 0.f;
#pragma unroll
        for (int e = 0; e < 8; ++e) { v[e] = bf2f(*(const LAS bf16_t*)(L + (dvg * 8 + e) * 132 + t * 2)); ss += v[e] * v[e]; }
        const float rs = rsqrtf(sum16(ss) * (1.0f / 128.0f) + EPS);
        u32x4 o;
        o[0] = pk2(v[0] * rs * ga[0] * silu(bflo(zr[0])), v[1] * rs * ga[1] * silu(bfhi(zr[0]))); o[1] = pk2(v[2] * rs * ga[2] * silu(bflo(zr[1])), v[3] * rs * ga[3] * silu(bfhi(zr[1])));
        o[2] = pk2(v[4] * rs * gb[0] * silu(bflo(zr[2])), v[5] * rs * gb[1] * silu(bfhi(zr[2]))); o[3] = pk2(v[6] * rs * gb[2] * silu(bflo(zr[3])), v[7] * rs * gb[3] * silu(bfhi(zr[3])));
        *(u32x4*)(OBm + tok * DM + h * 128 + dvg * 8) = o;
    }
    __syncthreads();
}

typedef __attribute__((address_space(1))) unsigned char* gptr_t;
DI unsigned char* opq(unsigned char* q) { gptr_t g = (gptr_t)q; asm volatile("" : "+s"(g)); return (unsigned char*)g; }
#define GIN(k) ((const float*)(const __attribute__((address_space(1))) float*)(pp->in[k]))
#define WSB opq(pp->ws)
#define DOB opq((unsigned char*)pp->out)
#define WAT ((bf16_t*)(WSB + WS_WAT))
#define WBT ((bf16_t*)(WSB + WS_WBT))
#define WOT ((bf16_t*)(WSB + WS_WOT))
#define WCT ((bf16_t*)(WSB + WS_WCT))
#define CMPC ((float*)(WSB + WS_CMPC))
#define CTR ((unsigned*)(WSB + WS_CTR))
#define KC ((bf16_t*)(WSB + WS_KC))
#define VCT ((bf16_t*)(WSB + WS_VCT))
#define SEL ((unsigned*)(WSB + WS_SEL))
#define GEXP ((float*)(WSB + WS_GEXP))
#define H ((bf16_t*)(WSB + WS_H))
#define WINT ((bf16_t*)(WSB + WS_WINT))
#define GQG ((bf16_t*)(WSB + WS_GQG))
#define GKGT ((bf16_t*)(WSB + WS_GKGT))
#define GW ((bf16_t*)(WSB + WS_GW))
#define PROJ ((bf16_t*)(WSB + WS_PROJ))
#define GUT ((bf16_t*)(WSB + WS_GU))
#define GQK ((bf16_t*)(WSB + WS_GQK))
#define VT ((bf16_t*)(WSB + WS_VT))
#define X1 ((float*)(WSB + WS_X1))
#define H2 ((bf16_t*)(WSB + WS_H2))
#define WGT ((bf16_t*)(WSB + WS_WGT))
#define WDT ((bf16_t*)(WSB + WS_WDT))
#define ACT ((bf16_t*)(WSB + WS_ACT))
#define OA ((bf16_t*)(DOB + DO_OA))
#define OBm ((bf16_t*)(DOB + DO_OB))
#define MIX ((bf16_t*)(DOB + DO_MIX))

typedef const Params __attribute__((address_space(4)))* ParamsK;
template <int PH> DI void run_phase(int half, LAS unsigned char* L) {
    ParamsK pp = (ParamsK)__builtin_amdgcn_kernarg_segment_ptr(); asm volatile("" : "+s"(pp));
    int tid = threadIdx.x, bid = blockIdx.x, G = gridDim.x;
    asm volatile("" : "+v"(tid)); asm volatile("" : "+s"(bid)); asm volatile("" : "+s"(G)); asm volatile("" : "+s"(half));
    LAS float* tile = (LAS float*)L;
    if (PH == 0) {
        if (bid == 0 && tid < 32) CTR[tid] = 0u;
        if (bid == 0 && tid == 32) CTR[64] = 0u;
        if (bid == 0) { unsigned* xb_ = (unsigned*)(WSB + WS_XBAR); for (int i = tid; i < 3456; i += 512) xb_[i] = 0u; }
        if (bid == 1 && tid < 64) {
            const float* qg = GIN(3); const float* kg = GIN(4);
            float mq = fmaxf(fabsf(qg[tid]), fabsf(qg[tid + 64]));
#pragma unroll
            for (int o = 32; o; o >>= 1) mq = fmaxf(mq, __shfl_xor(mq, o));
#pragma unroll
            for (int br = 0; br < 3; ++br) { float mk = fmaxf(fabsf(kg[br * 128 + tid]), fabsf(kg[br * 128 + tid + 64]));
#pragma unroll
                for (int o = 32; o; o >>= 1) mk = fmaxf(mk, __shfl_xor(mk, o));
                if (tid == 0) ((float*)(CTR + 40))[br] = QSCALE * 128.0f * mq * mk; }
        }
        xpose_all<0>(tile, GIN(11), 2048, 2048, WAT, tid, bid, G);
        xpose_all<0>(tile, GIN(12), 2048, 2048, WBT, tid, bid, G);
        xpose_all<0>(tile, GIN(13), 2048, 2048, WOT, tid, bid, G);
        xpose_all<0>(tile, GIN(6), 4096, 128, WCT, tid, bid, G);
        xpose_all<0>(tile, GIN(6) + 4096 * 128, 4096, 128, WCT + 128 * 4096, tid, bid, G);
        xpose_all<1>(tile, GIN(2), 2048, 17488, WINT, tid, bid, G);
        norm_rows(GIN(0), GIN(1), H, TH, tid, bid, G);
        if (bid >= G - 16) {
            const int idx = bid - (G - 16), kv = idx >> 3, ks = idx & 7, e = tid & 127, part = tid >> 7;
            const float* pos = GIN(5) + kv * 4096 + ks * 512 + part * 128; const float* wc = GIN(6) + ((size_t)kv * 4096 + ks * 512 + part * 128) * 128 + e;
            float s[8];
#pragma unroll
            for (int j = 0; j < 8; ++j) s[j] = 0.f;
#pragma unroll 1
            for (int k = 0; k < 128; k += 8) {
#pragma unroll
                for (int j = 0; j < 8; ++j) s[j] += pos[k + j] * wc[(size_t)(k + j) * 128];
            }
            tile[tid] = ((s[0] + s[1]) + (s[2] + s[3])) + ((s[4] + s[5]) + (s[6] + s[7])); __syncthreads();
            if (tid < 128) CMPC[(kv * 8 + ks) * 128 + tid] = tile[tid] + tile[tid + 128] + tile[tid + 256] + tile[tid + 384];
            __syncthreads();
        }
    }
    if (PH == 1) { if (half == 0) norm_rows(GIN(0) + (size_t)TH * DM, GIN(1), H, TH, tid, bid, G); }
    if (PH == 2) { EpiProj E{PROJ}; run_gemm(L, H, WINT, TH, NP, 2048, E); }
    if (PH == 3) {
        LAS int* qw = (LAS int*)(L + 131072 + 64);
        int nxt = 0;
        if (tid == 0) nxt = (int)atomicAdd(CTR + 2 + half, 1u);
        for (;;) {
            if (tid == 0) *qw = nxt;
            __syncthreads();
            const int it = *qw;
            __syncthreads();
            if (it >= 64 + 2048 + 1024 + 512) break;
            if (tid == 0) nxt = (int)atomicAdd(CTR + 2 + half, 1u);
            if (it < 64) cmp_item(L, PROJ, WCT, CMPC, GIN(4), KC, VCT, it, tid);
            else if (it < 64 + 2048) gdn_prep_item(L, PROJ, GIN(7), GIN(8), GIN(9), GQG, GKGT, GW, GUT, GQK, GEXP, it - 64, tid);
            else if (it < 64 + 2048 + 1024) vt_item(L, PROJ, VT, it - 64 - 2048, tid);
            else qk_norm_item(PROJ, GIN(3), GIN(4), it - 64 - 2048 - 1024, tid);
        }
    }
    if (PH == 6) for (int it = bid; it < 512; it += G) cmp_attn_item(L, PROJ, KC, VCT, OA, SEL, (const float*)(CTR + 40), it, tid);
    if (PH == 7) { if (bid < 32) gdn_scan2(L, GQG, GKGT, GW, GUT, GQK, GEXP, bid, tid); }
    if (PH == 8) {
        int k = 0;
        for (;;) {
            LAS int* qw = (LAS int*)(L + AT_MISC + 64);
            if (tid == 0) { int it = -1;
                while (k < 8) { const int q = (bid + k) & 7; const unsigned t = atomicAdd(CTR + 8 + 8 * half + q, 1u); if (t < 64u) { it = (int)t * 8 + q; break; } ++k; }
                *qw = it; }
            __syncthreads();
            const int it = *qw;
            __syncthreads();
            if (it < 0) break;
            attn_item(L, PROJ, VT, SEL, OA, (const float*)(CTR + 40), it, tid);
        }
    }
    if (PH == 9) for (int it = bid; it < 2048; it += G) obnorm_item(L, GUT, PROJ, GIN(10), OBm, it, tid);
    if (PH == 10) {
        EpiMix2 E{MIX + (size_t)half * TH * DM, PROJ};
        pg8::Gemm g{OA, WAT, 2 * TH, 4096, 2048}; BrOrder S; S.init(TH, 2048, (int)gridDim.x, (int)blockIdx.x);
        pg8::gemm_phase<EpiMix2, BrOrder, false>((PG8_LAS unsigned char*)L, g, S, E, nullptr);
        __syncthreads();
    }
    if (PH == 12) {
        xpose_all<2>(tile, GIN(15), 2048, DFF, WGT, tid, bid, G);
        xpose_all<3>(tile, GIN(16), 2048, DFF, WGT, tid, bid, G);
        xpose_all<0>(tile, GIN(17), DFF, 2048, WDT, tid, bid, G);
    }
    if (PH == 13) { EpiRes E{X1, GIN(0)}; run_gemm_half(L, MIX, WOT, 2 * TH, 2048, 2048, E); }
    if (PH == 14) norm_rows(X1, GIN(14), H2, 2 * TH, tid, bid, G);
    if (PH == 15) { EpiGU E{ACT}; run_gemm(L, H2, WGT, 2 * TH, 2 * DFF, 2048, E); }
    if (PH == 16) { EpiRes E{(float*)(__attribute__((address_space(1))) float*)pp->out, X1}; run_gemm_half(L, ACT, WDT, 2 * TH, 2048, DFF, E); }
}
constexpr int LDS_BYTES = 132 * 1024;
DI void gbar(unsigned* bar, unsigned target) {
    asm volatile("s_waitcnt vmcnt(0) lgkmcnt(0)" ::: "memory");
    __syncthreads();
    if (threadIdx.x == 0) {
        __builtin_amdgcn_fence(__ATOMIC_RELEASE, "agent");
        asm volatile("s_waitcnt vmcnt(0)" ::: "memory");
        __hip_atomic_fetch_add(bar, 1u, __ATOMIC_RELAXED, __HIP_MEMORY_SCOPE_AGENT);
        while (__hip_atomic_load(bar, __ATOMIC_RELAXED, __HIP_MEMORY_SCOPE_AGENT) < target) __builtin_amdgcn_s_sleep(1);
        __builtin_amdgcn_fence(__ATOMIC_ACQUIRE, "agent");
        asm volatile("s_waitcnt vmcnt(0)" ::: "memory");
    }
    __syncthreads();
}
#define XB_TMO      128
#define XB_XCNT(j)  (256  + 64 * (j))
#define XB_XSUB(j)  (1280 + 64 * (j))
#define XB_XGEN(j)  (2304 + 64 * (j))
#define XB_TOP      3328
#define XB_TOPGEN   3392
#define XCD_BAR_WORDS 3456
#define XB_SPIN_CAP (1u << 18)
__device__ __forceinline__ unsigned xb_ld(unsigned* p)              { return __hip_atomic_load(p, __ATOMIC_RELAXED, __HIP_MEMORY_SCOPE_AGENT); }
__device__ __forceinline__ unsigned xb_add(unsigned* p, unsigned v) { return __hip_atomic_fetch_add(p, v, __ATOMIC_RELAXED, __HIP_MEMORY_SCOPE_AGENT); }
__device__ __forceinline__ unsigned xb_xcc_id() { return (unsigned)__builtin_amdgcn_s_getreg((3 << 11) | 20) & 0xFu; }
#define XB_SPIN(cond, bar) do { unsigned _sp = 0; while (cond) { __builtin_amdgcn_s_sleep(1); \
    if ((++_sp & 255u) == 0u) { if (xb_ld(&(bar)[XB_TMO])) break; if (_sp > XB_SPIN_CAP) { atomicAdd(&(bar)[XB_TMO], 1u); break; } } } } while (0)

struct XcdBarrier {
    unsigned* bar; unsigned x;
    volatile LAS unsigned* st;
};

__device__ __forceinline__ XcdBarrier xcd_barrier_post(unsigned* bar, volatile LAS unsigned* st) {
    XcdBarrier b; b.bar = bar; b.x = xb_xcc_id(); b.st = st;
    if (threadIdx.x == 0) (void)xb_add(&bar[XB_XCNT(b.x)], 1u);
    return b;
}
__device__ __forceinline__ void xcd_barrier_complete(unsigned* bar, unsigned x, unsigned& nloc, unsigned& nx) {
    const unsigned G = gridDim.x * gridDim.y * gridDim.z;
    unsigned sum, cnt, mine, sp = 0u;
    for (;;) {
        sum = 0u; cnt = 0u; mine = 0u;
#pragma unroll
        for (unsigned j = 0; j < 16; ++j) { const unsigned c = xb_ld(&bar[XB_XCNT(j)]); sum += c; cnt += (c > 0u) ? 1u : 0u; mine = (j == x) ? c : mine; }
        if (sum == G) break;
        __builtin_amdgcn_s_sleep(1);
        if ((++sp & 255u) == 0u) { if (xb_ld(&bar[XB_TMO])) break; if (sp > XB_SPIN_CAP) { atomicAdd(&bar[XB_TMO], 1u); break; } }
    }
    nloc = mine > 0u ? mine : 1u; nx = cnt > 0u ? cnt : 1u;
}

__device__ __forceinline__ void xcd_barrier(const XcdBarrier& b) {
    asm volatile("s_waitcnt vmcnt(0)" ::: "memory");
    __syncthreads();
    if (threadIdx.x == 0) {
        unsigned* bar = b.bar;
        __builtin_amdgcn_s_waitcnt(0);
        unsigned nloc = b.st[0], nx = b.st[1];
        if (nloc == 0u) { xcd_barrier_complete(bar, b.x, nloc, nx); b.st[0] = nloc; b.st[1] = nx; }
        const unsigned old = xb_add(&bar[XB_XSUB(b.x)], 1u);
        const unsigned gen = old / nloc;
        if (old + 1u == (gen + 1u) * nloc) {
            __builtin_amdgcn_fence(__ATOMIC_RELEASE, "agent");
            asm volatile("s_waitcnt vmcnt(0)" ::: "memory");
            const unsigned og = xb_add(&bar[XB_TOP], 1u);
            const unsigned tg = og / nx;
            if (og + 1u == (tg + 1u) * nx) xb_add(&bar[XB_TOPGEN], 1u);
            else XB_SPIN(xb_ld(&bar[XB_TOPGEN]) == tg, bar);
            __builtin_amdgcn_fence(__ATOMIC_ACQUIRE, "agent");
            xb_add(&bar[XB_XGEN(b.x)], 1u);
            asm volatile("s_waitcnt vmcnt(0)" ::: "memory");
        } else {
            XB_SPIN(xb_ld(&bar[XB_XGEN(b.x)]) == gen, bar);
            __builtin_amdgcn_fence(__ATOMIC_ACQUIRE, "agent");
            asm volatile("s_waitcnt vmcnt(0)" ::: "memory");
        }
    }
    __syncthreads();
}
#ifndef PROBE_PH
#define PROBE_PH -1
#endif
#define RP(X, h) do { if (PROBE_PH == (X)) { const unsigned long long t0_ = __builtin_amdgcn_s_memrealtime(); run_phase<X>(h, L); const unsigned long long t1_ = __builtin_amdgcn_s_memrealtime(); \
    while (__builtin_amdgcn_s_memrealtime() - t1_ < t1_ - t0_) __builtin_amdgcn_s_sleep(8); } else run_phase<X>(h, L); } while (0)
__global__ void __launch_bounds__(512, 2) mega(Params p) {
    extern __shared__ __attribute__((aligned(16))) unsigned char smem[];
    LAS unsigned char* L = (LAS unsigned char*)smem;
    cg::grid_group grid = cg::this_grid();
    volatile LAS unsigned* xst = (volatile LAS unsigned*)(L + 135152);
    if (threadIdx.x == 0) { xst[0] = 0u; xst[1] = 0u; }
    __syncthreads();
    XcdBarrier xb;
#define GB() xcd_barrier(xb)
    RP(0, 0); grid.sync();
    { ParamsK pp = (ParamsK)__builtin_amdgcn_kernarg_segment_ptr(); xb = xcd_barrier_post((unsigned*)(__attribute__((address_space(1))) unsigned*)(pp->ws + WS_XBAR), xst); }
#pragma unroll 1
    for (int half = 0; half < 2; ++half) {
        RP(2, half); GB();
        RP(3, half); GB();
        RP(6, half); GB();
        RP(7, half); RP(8, half); GB();
        RP(9, half); RP(1, half); GB();
        RP(10, half); GB();
    }
    RP(12, 0); RP(13, 0); GB();
    RP(14, 0); GB();
    RP(15, 0); GB();
    RP(16, 0);
}
extern "C" void kernel_launch(void* const* d_in, const int* in_sizes, int n_in, void* d_out, int out_size, void* d_ws, size_t ws_size, hipStream_t stream) {
    static int grid = 0;
    if (grid == 0) {
        int dev = 0, cus = 0, per_cu = 0;
        (void)hipGetDevice(&dev); (void)hipDeviceGetAttribute(&cus, hipDeviceAttributeMultiprocessorCount, dev);
        if (hipFuncSetAttribute((const void*)mega, hipFuncAttributeMaxDynamicSharedMemorySize, LDS_BYTES) != hipSuccess) fprintf(stderr, "hipFuncSetAttribute failed\n");
        if (hipOccupancyMaxActiveBlocksPerMultiprocessor(&per_cu, (const void*)mega, 512, LDS_BYTES) != hipSuccess || per_cu < 1) { fprintf(stderr, "occupancy query: %d\n", per_cu); per_cu = 1; }
        (void)hipGetLastError();
        grid = cus;
    }
    Params p{};
    for (int i = 0; i < 18; ++i) p.in[i] = (const float*)d_in[i];
    p.out = (float*)d_out; p.ws = (unsigned char*)d_ws;
    void* args[] = {&p};
    hipError_t e = hipLaunchCooperativeKernel((const void*)mega, dim3(grid), dim3(512), args, LDS_BYTES, stream);
    if (e != hipSuccess) fprintf(stderr, "cooperative launch failed: %s (grid %d)\n", hipGetErrorString(e), grid);
}
```

```cpp
#include <hip/hip_runtime.h>
#include <hip/hip_cooperative_groups.h>
#include <cstdio>
namespace cg = cooperative_groups;
namespace pg8 {
#define PG8_LAS __attribute__((address_space(3)))
typedef unsigned short bf16_t;
typedef short bf16x8 __attribute__((ext_vector_type(8)));
typedef float f32x4 __attribute__((ext_vector_type(4)));
typedef unsigned u32x4 __attribute__((ext_vector_type(4)));
constexpr int BM = 256, BK = 64, HALF = 128, HTB = HALF * BK * 2  , STAGE_BYTES = 8 * HTB, NXCD = 8, WGM = 8;

__host__ __device__ __forceinline__ int lds_byte(int r, int c) { const int st = (r >> 4) * 2 + (c >> 5), rr = r & 15, cc = c & 31, ob = rr * 64 + cc * 2; return st * 1024 + (ob ^ (((ob >> 9) & 1) << 5)); }
__host__ __device__ __forceinline__ void stage_rc(int b, int& R, int& C) { const int st = b / 1024, sb = b % 1024, swz = sb ^ (((sb >> 9) & 1) << 5); R = (st >> 1) * 16 + swz / 64; C = (st & 1) * 32 + (swz % 64) / 2; }
__host__ __device__ __forceinline__ int perm32(int rho) { const int n = rho >> 4, i = rho & 15; return 8 * (i >> 2) + 4 * n + (i & 3); }

struct Unit { int pm, pn; };
struct Gemm { const bf16_t* A; const bf16_t* Bt; int M, N, K; };

struct StaticOrder {
    int nM, nN, nwg, G, c;
    __host__ __device__ void init(int M, int N, int G_, int c_) { nM = M / BM; nN = N / BM; nwg = nM * nN; G = G_; c = c_; }
    __host__ __device__ bool next(int i, Unit& u) const {
        const long L = (long)i * G + c; if (L >= nwg) return false;
        int wgid = (int)L; { const int q = nwg / NXCD, r = nwg % NXCD, xcd = wgid % NXCD, off = wgid / NXCD; wgid = (xcd < r ? xcd * (q + 1) : r * (q + 1) + (xcd - r) * q) + off; }
        const int nig = WGM * nN, gid = wgid / nig, fm = gid * WGM, gsz = (nM - fm) < WGM ? (nM - fm) : WGM;
        u.pm = fm + ((wgid % nig) % gsz); u.pn = (wgid % nig) / gsz; return true;
    }
    __device__ __forceinline__ void a_ready(const Unit&) const {}
    __device__ __forceinline__ void done(const Unit&) const {}
};
__device__ __forceinline__ unsigned cvt_pk_bf16(float lo, float hi) { unsigned r; asm volatile("v_cvt_pk_bf16_f32 %0, %1, %2" : "=v"(r) : "v"(lo), "v"(hi)); return r; }

template <class Epi, class Sched, bool STAMP = false>
__device__ __forceinline__ void gemm_phase(PG8_LAS unsigned char* lds, const Gemm g, const Sched& S, const Epi& E, unsigned long long* stamps) {
    int tid_ = threadIdx.x; asm volatile("" : "+v"(tid_));
    const int tid = tid_, wid = __builtin_amdgcn_readfirstlane(tid >> 6), lane = tid & 63, wr = wid >> 2, wc = wid & 3, fr = lane & 15, fq = lane >> 4;
    const int K = g.K, nt = K / BK;
    int ts_lo = 0, ts_hi = 0, nts = 0; const unsigned long long rt_entry = STAMP ? (unsigned long long)wall_clock64() : 0ull;
#define PG8_STAMP() do { if (STAMP && wid == 0 && nts < 64) { const unsigned long long _c = (unsigned long long)clock64(); \
        ts_lo = (lane == nts) ? (int)(unsigned)_c : ts_lo; ts_hi = (lane == nts) ? (int)(unsigned)(_c >> 32) : ts_hi; ++nts; } } while (0)
    PG8_STAMP();
    unsigned voffA[2], voffB[2];
#pragma unroll
    for (int i = 0; i < 2; ++i) { int R, C; stage_rc(tid * 16 + i * 8192, R, C); const int Rb = Epi::PERM ? ((R & ~31) + perm32(R & 31)) : R;
        voffA[i] = (unsigned)(R * K + C) * 2u; voffB[i] = (unsigned)(Rb * K + C) * 2u; }
    const size_t kstep = (size_t)(BK * 2);
    const size_t hstep = (size_t)HALF * K * 2;
    const size_t tstep = 2 * hstep;
    const unsigned ldsw = (unsigned)wid * 1024u;
    const int aoff = lds_byte(wr * 64 + fr, fq * 8), boff = lds_byte(wc * 32 + fr, fq * 8);
#define PG8_SA(b, h) (((b) * 2 + (h)) * HTB)
#define PG8_SB(b, h) ((4 + (b) * 2 + (h)) * HTB)
#define PG8_STAGE(bufoff, gbase, voff) do { _Pragma("unroll") for (int _i = 0; _i < 2; ++_i) \
        __builtin_amdgcn_global_load_lds((const unsigned*)((const char*)(gbase) + (voff)[_i]), (PG8_LAS unsigned*)(lds + (bufoff) + ldsw + _i * 8192), 16, 0, 0); } while (0)
#define PG8_LDA(dst, b, h) do { _Pragma("unroll") for (int m = 0; m < 4; ++m) _Pragma("unroll") for (int k = 0; k < 2; ++k) dst[m][k] = *(const PG8_LAS bf16x8*)(lds + PG8_SA(b, h) + aoff + m * 2048 + k * 1024); } while (0)
#define PG8_LDB(dst, b, h) do { _Pragma("unroll") for (int n = 0; n < 2; ++n) _Pragma("unroll") for (int k = 0; k < 2; ++k) dst[n][k] = *(const PG8_LAS bf16x8*)(lds + PG8_SB(b, h) + boff + n * 2048 + k * 1024); } while (0)
#define PG8_MMA(ai, bj, At, Bt) do { __builtin_amdgcn_s_setprio(1); _Pragma("unroll") for (int m = 0; m < 4; ++m) _Pragma("unroll") for (int n = 0; n < 2; ++n) _Pragma("unroll") for (int k = 0; k < 2; ++k) \
        acc[ai][bj][m][n] = __builtin_amdgcn_mfma_f32_16x16x32_bf16(Bt[n][k], At[m][k], acc[ai][bj][m][n], 0, 0, 0); __builtin_amdgcn_s_setprio(0); } while (0)
#define PG8_WAIT_V(n) asm volatile("s_waitcnt vmcnt(" #n ")" ::: "memory")
#define PG8_WAIT_L(n) asm volatile("s_waitcnt lgkmcnt(" #n ")" ::: "memory")
#define PG8_BAR __builtin_amdgcn_s_barrier()
#define PG8_SCHED __builtin_amdgcn_sched_barrier(0)
    Unit cur, nxt; int ui = 0;
    if (!S.next(0, cur)) return;
    f32x4 acc[2][2][4][2];
#pragma unroll
    for (int a = 0; a < 2; ++a)
#pragma unroll
        for (int b = 0; b < 2; ++b)
#pragma unroll
            for (int m = 0; m < 4; ++m)
#pragma unroll
                for (int n = 0; n < 2; ++n) acc[a][b][m][n] = (f32x4){0.f, 0.f, 0.f, 0.f};
    bf16x8 At[4][2], B0[2][2], B1[2][2];
    const char* cA = (const char*)g.A + (size_t)cur.pm * tstep; const char* cB = (const char*)g.Bt + (size_t)cur.pn * tstep;
    S.a_ready(cur);
    PG8_STAGE(PG8_SB(0, 0), cB, voffB); PG8_STAGE(PG8_SA(0, 0), cA, voffA); PG8_STAGE(PG8_SB(0, 1), cB + hstep, voffB); PG8_STAGE(PG8_SA(0, 1), cA + hstep, voffA);
    if (wr == 1) PG8_BAR;
    PG8_WAIT_V(4); PG8_BAR;
    PG8_STAGE(PG8_SB(1, 0), cB + kstep, voffB); PG8_STAGE(PG8_SA(1, 0), cA + kstep, voffA); PG8_STAGE(PG8_SB(1, 1), cB + hstep + kstep, voffB);
    PG8_WAIT_V(6); PG8_BAR;
    PG8_STAMP();
    for (;;) {
        const bool has_next = S.next(ui + 1, nxt);
        const char* nA = has_next ? (const char*)g.A + (size_t)nxt.pm * tstep : cA; const char* nB = has_next ? (const char*)g.Bt + (size_t)nxt.pn * tstep : cB;
        for (int t = 0; t < nt; t += 2) {
            const bool last = (t == nt - 2);
            const char* a1 = cA + (size_t)(t + 1) * kstep;
            const char* a2 = last ? nA : cA + (size_t)(t + 2) * kstep; const char* b2 = last ? nB : cB + (size_t)(t + 2) * kstep;
            const char* a3 = a2 + kstep; const char* b3 = b2 + kstep;
            if (last && has_next) S.a_ready(nxt);
            PG8_LDB(B0, 0, 0); PG8_SCHED; PG8_LDA(At, 0, 0); PG8_STAGE(PG8_SA(1, 1), a1 + hstep, voffA);
            PG8_WAIT_L(8); PG8_BAR; PG8_WAIT_L(0); PG8_MMA(0, 0, At, B0); PG8_BAR; PG8_SCHED;
            PG8_LDB(B1, 0, 1); PG8_STAGE(PG8_SB(0, 0), b2, voffB);
            PG8_BAR; PG8_WAIT_L(0); PG8_MMA(0, 1, At, B1); PG8_BAR;
            PG8_LDA(At, 0, 1); PG8_STAGE(PG8_SA(0, 0), a2, voffA);
            PG8_BAR; PG8_WAIT_L(0); PG8_MMA(1, 0, At, B0); PG8_BAR; PG8_SCHED;
            PG8_STAGE(PG8_SB(0, 1), b2 + hstep, voffB);
            PG8_WAIT_V(6); PG8_BAR; PG8_MMA(1, 1, At, B1); PG8_BAR;
            PG8_LDB(B0, 1, 0); PG8_SCHED; PG8_LDA(At, 1, 0); PG8_STAGE(PG8_SA(0, 1), a2 + hstep, voffA);
            PG8_WAIT_L(8); PG8_BAR; PG8_WAIT_L(0); PG8_MMA(0, 0, At, B0); PG8_BAR; PG8_SCHED;
            PG8_LDB(B1, 1, 1); PG8_STAGE(PG8_SB(1, 0), b3, voffB);
            PG8_BAR; PG8_WAIT_L(0); PG8_MMA(0, 1, At, B1); PG8_BAR;
            PG8_LDA(At, 1, 1); PG8_STAGE(PG8_SA(1, 0), a3, voffA);
            PG8_BAR; PG8_WAIT_L(0); PG8_MMA(1, 0, At, B0); PG8_BAR; PG8_SCHED;
            PG8_STAGE(PG8_SB(1, 1), b3 + hstep, voffB);
            PG8_WAIT_V(6); PG8_BAR; PG8_MMA(1, 1, At, B1); PG8_BAR;
        }
        PG8_STAMP();
        bool keep_acc = false;
        if constexpr (!Epi::AFTER_DRAIN) {
            if constexpr (Epi::CHAIN) { keep_acc = E.first(cur); if (keep_acc) E.mid(acc, cur, wr, wc, fr, fq); else E(acc, cur, wr, wc, fr, fq); }
            else E(acc, cur, wr, wc, fr, fq);
            S.done(cur); }
        PG8_STAMP();
        if (!has_next) break;
        if (!keep_acc)
#pragma unroll
        for (int a = 0; a < 2; ++a)
#pragma unroll
            for (int b = 0; b < 2; ++b)
#pragma unroll
                for (int m = 0; m < 4; ++m)
#pragma unroll
                    for (int n = 0; n < 2; ++n) acc[a][b][m][n] = (f32x4){0.f, 0.f, 0.f, 0.f};
        cur = nxt; cA = nA; cB = nB; ++ui;
    }
    PG8_WAIT_V(0);
    if (wr == 0) PG8_BAR;
    PG8_BAR;
    if constexpr (Epi::AFTER_DRAIN) { E.fused(acc, cur, wr, wc, fr, fq, lds, wid, lane); S.done(cur); }
    PG8_STAMP();
    if (STAMP && wid == 0) { stamps[lane] = lane < nts ? (((unsigned long long)(unsigned)ts_hi << 32) | (unsigned)ts_lo) : 0ull;
        if (lane == 62) stamps[62] = rt_entry; if (lane == 63) stamps[63] = (unsigned long long)wall_clock64(); }
#undef PG8_STAMP
#undef PG8_SA
#undef PG8_SB
#undef PG8_STAGE
#undef PG8_LDA
#undef PG8_LDB
#undef PG8_MMA
#undef PG8_WAIT_V
#undef PG8_WAIT_L
#undef PG8_BAR
#undef PG8_SCHED
}
}

#define DI __device__ __forceinline__
#define LAS __attribute__((address_space(3)))
typedef unsigned short bf16_t;
typedef short bf16x8 __attribute__((ext_vector_type(8)));
typedef float f32x4 __attribute__((ext_vector_type(4)));
typedef float f32x16 __attribute__((ext_vector_type(16)));
typedef unsigned u32x4 __attribute__((ext_vector_type(4)));
typedef unsigned u32x2 __attribute__((ext_vector_type(2)));
typedef __bf16 bf2_t __attribute__((ext_vector_type(2)));
typedef float f2_t __attribute__((ext_vector_type(2)));
typedef unsigned long long u64;

constexpr int TH = 8192, SEQ = 4096, DM = 2048, NP = 17664, DFF = 5632;
constexpr int C_KV = 2048, C_GQ = 5120, C_Z = 11264, C_MA = 13312, C_MB = 15360, C_GATE = 17408, C_A = 17456, C_B = 17472;
constexpr float EPS = 1e-6f;
constexpr float QSCALE = 0.08838834764831845f * 1.4426950408889634f;

constexpr size_t WS_WAT = 0, WS_WBT = 8388608, WS_WOT = 16777216, WS_WCT = 25165824, WS_CMPC = 563359744, WS_CTR = 27264000,
                 WS_KC = 27267072, WS_VCT = 27791360, WS_SEL = 28315648, WS_GEXP = 28577792, WS_X = 28585984,
                 WS_H = WS_X, WS_WINT = 491008000, WS_GQG = WS_X, WS_GKGT = WS_X + 33554432, WS_GW = WS_X + 67108864,
                 WS_PROJ = 134492160, WS_GU = 423899136, WS_GQK = 457453568, WS_VT = 474230784,
                 WS_X1 = WS_X, WS_H2 = 162803712, WS_WGT = 229912576, WS_WDT = 276049920, WS_ACT = 299118592;
constexpr size_t DO_OA = 0, DO_OB = 33554432, DO_MIX = 67108864;

struct Params { const float* in[18]; float* out; unsigned char* ws; };

DI unsigned pk2(float a, float b) { f2_t v = {a, b}; return __builtin_bit_cast(unsigned, __builtin_convertvector(v, bf2_t)); }
DI float bflo(unsigned u) { return __uint_as_float(u << 16); }
DI float bfhi(unsigned u) { return __uint_as_float(u & 0xffff0000u); }
DI float bf2f(bf16_t h) { return __uint_as_float((unsigned)h << 16); }
DI bf16_t f2bf(float x) { return (bf16_t)(pk2(x, 0.f) & 0xffffu); }
template <int CTRL> DI float dppf(float v) { return __int_as_float(__builtin_amdgcn_update_dpp(0, __float_as_int(v), CTRL, 0xF, 0xF, true)); }
DI float sum8(float v) { v += dppf<0xB1>(v); v += dppf<0x4E>(v); v += dppf<0x141>(v); return v; }
DI float sum16(float v) { v = sum8(v); v += dppf<0x140>(v); return v; }
DI float wsum(float v) { v = sum16(v); v += __shfl_xor(v, 16); v += __shfl_xor(v, 32); return v; }
DI float sigm(float x) { return __builtin_amdgcn_rcpf(1.0f + __expf(-x)); }
DI float silu(float x) { return x * __builtin_amdgcn_rcpf(1.0f + __expf(-x)); }
DI f32x16 mfma32(bf16x8 a, bf16x8 b, f32x16 c) { return __builtin_amdgcn_mfma_f32_32x32x16_bf16(a, b, c, 0, 0, 0); }
DI f32x16 zero16() { f32x16 z; for (int i = 0; i < 16; ++i) z[i] = 0.f; return z; }
DI int crow(int reg, int h) { return (reg & 3) + 8 * (reg >> 2) + 4 * h; }
DI bf16x8 pack8(const f32x16& x, int s) { u32x4 p; p[0] = pk2(x[8 * s], x[8 * s + 1]); p[1] = pk2(x[8 * s + 2], x[8 * s + 3]); p[2] = pk2(x[8 * s + 4], x[8 * s + 5]); p[3] = pk2(x[8 * s + 6], x[8 * s + 7]); return __builtin_bit_cast(bf16x8, p); }
DI bf16x8 cat8(u32x2 a, u32x2 b) { u32x4 p = {a[0], a[1], b[0], b[1]}; return __builtin_bit_cast(bf16x8, p); }

template <int MAP> DI int map_row(int n) {
    if (MAP == 0) return n;
    if (MAP == 1) { if (n < 5120) return n; if (n < 5168) return 17408 + (n - 5120); if (n < 13360) return n - 48; if (n < 13376) return 17456 + (n - 13360); if (n < 13392) return 17472 + (n - 13376); return n - 80; }
    if (MAP == 2) return (n >> 7) * 256 + (n & 127);
    return (n >> 7) * 256 + 128 + (n & 127);
}
DI void xpose_ld(f32x4 (&v)[8], const float* src, int N, int kt, int nt, int tid) {
    const int k0 = kt * 64, n = nt * 256 + (tid & 63) * 4, r = tid >> 6;
#pragma unroll
    for (int i = 0; i < 8; ++i) { v[i] = (f32x4){0.f, 0.f, 0.f, 0.f}; if (n < N) v[i] = *(const f32x4*)(src + (size_t)(k0 + r + 8 * i) * N + n); }
}
template <int MAP> DI void xpose_put(LAS float* tile, const f32x4 (&v)[8], int K, int N, bf16_t* dst, int kt, int nt, int tid) {
    const int k0 = kt * 64, n0 = nt * 256, r = tid >> 6, c4 = (tid & 63) * 4;
#pragma unroll
    for (int i = 0; i < 8; ++i) { LAS float* d = tile + (r + 8 * i) * 257 + c4; d[0] = v[i][0]; d[1] = v[i][1]; d[2] = v[i][2]; d[3] = v[i][3]; }
    __syncthreads();
    const int kc = tid & 7;
#pragma unroll
    for (int ps = 0; ps < 4; ++ps) { const int nl = ps * 64 + (tid >> 3), n = n0 + nl;
        if (n < N) { u32x4 w;
#pragma unroll
            for (int j = 0; j < 4; ++j) w[j] = pk2(tile[(kc * 8 + 2 * j) * 257 + nl], tile[(kc * 8 + 2 * j + 1) * 257 + nl]);
            *(u32x4*)(dst + (size_t)map_row<MAP>(n) * K + k0 + kc * 8) = w; } }
    __syncthreads();
}
template <int MAP> DI void xpose_all(LAS float* tile, const float* src, int K, int N, bf16_t* dst, int tid, int bid, int G) {
    const int nkt = K / 64, nnt = (N + 255) / 256, tot = nkt * nnt;
    f32x4 va[8], vb[8];
    int i = bid;
    if (i < tot) xpose_ld(va, src, N, i / nnt, i % nnt, tid);
    for (; i < tot; i += 2 * G) {
        const int i1 = i + G, i2 = i + 2 * G;
        if (i1 < tot) xpose_ld(vb, src, N, i1 / nnt, i1 % nnt, tid);
        xpose_put<MAP>(tile, va, K, N, dst, i / nnt, i % nnt, tid);
        if (i1 < tot) {
            if (i2 < tot) xpose_ld(va, src, N, i2 / nnt, i2 % nnt, tid);
            xpose_put<MAP>(tile, vb, K, N, dst, i1 / nnt, i1 % nnt, tid);
        }
    }
}
DI void norm_rows(const float* x, const float* gain, bf16_t* out, int nrows, int tid, int bid, int G) {
    const int w = tid >> 6, lane = tid & 63;
    for (int row = bid * 8 + w; row < nrows; row += G * 8) {
        f32x4 v[8]; float ss = 0.f;
#pragma unroll
        for (int i = 0; i < 8; ++i) { v[i] = *(const f32x4*)(x + (size_t)row * DM + i * 256 + lane * 4); ss += v[i][0] * v[i][0] + v[i][1] * v[i][1] + v[i][2] * v[i][2] + v[i][3] * v[i][3]; }
        ss = wsum(ss); const float rs = rsqrtf(ss * (1.0f / DM) + EPS);
#pragma unroll
        for (int i = 0; i < 8; ++i) { const f32x4 gn = *(const f32x4*)(gain + i * 256 + lane * 4);
            u32x2 o; o[0] = pk2(v[i][0] * rs * gn[0], v[i][1] * rs * gn[1]); o[1] = pk2(v[i][2] * rs * gn[2], v[i][3] * rs * gn[3]);
            *(u32x2*)(out + (size_t)row * DM + i * 256 + lane * 4) = o; }
    }
}

struct EpiProj { static constexpr bool PERM = true, AFTER_DRAIN = false, CHAIN = false; bf16_t* O;
    DI void operator()(const pg8::f32x4 (&acc)[2][2][4][2], const pg8::Unit& u, int wr, int wc, int fr, int fq) const {
        const int row0 = u.pm * 256 + wr * 64 + fr, col0 = u.pn * 256 + wc * 32 + 8 * fq;
#pragma unroll
        for (int ai = 0; ai < 2; ++ai)
#pragma unroll
            for (int m = 0; m < 4; ++m) { bf16_t* rowp = O + (size_t)(row0 + ai * 128 + m * 16) * NP + col0;
#pragma unroll
                for (int bj = 0; bj < 2; ++bj) { const pg8::f32x4 v0 = acc[ai][bj][m][0], v1 = acc[ai][bj][m][1];
                    u32x4 w; w[0] = pk2(v0[0], v0[1]); w[1] = pk2(v0[2], v0[3]); w[2] = pk2(v1[0], v1[1]); w[3] = pk2(v1[2], v1[3]);
                    *(u32x4*)(rowp + bj * 128) = w; } }
    } };
template <bool ADD> struct EpiMix { static constexpr bool PERM = true, AFTER_DRAIN = false, CHAIN = false; bf16_t* MIX; const bf16_t* gate;
    DI void operator()(const pg8::f32x4 (&acc)[2][2][4][2], const pg8::Unit& u, int wr, int wc, int fr, int fq) const {
        const int row0 = u.pm * 256 + wr * 64 + fr, col0 = u.pn * 256 + wc * 32 + 8 * fq;
#pragma unroll
        for (int ai = 0; ai < 2; ++ai)
#pragma unroll
            for (int m = 0; m < 4; ++m) { const int row = row0 + ai * 128 + m * 16;
#pragma unroll
                for (int bj = 0; bj < 2; ++bj) { const pg8::f32x4 v0 = acc[ai][bj][m][0], v1 = acc[ai][bj][m][1];
                    const u32x4 gt = *(const u32x4*)(gate + (size_t)row * NP + col0 + bj * 128);
                    float o[8] = {v0[0], v0[1], v0[2], v0[3], v1[0], v1[1], v1[2], v1[3]};
#pragma unroll
                    for (int j = 0; j < 4; ++j) { o[2 * j] *= sigm(bflo(gt[j])); o[2 * j + 1] *= sigm(bfhi(gt[j])); }
                    bf16_t* dp = MIX + (size_t)row * DM + col0 + bj * 128;
                    if (ADD) { const u32x4 pr = *(const u32x4*)dp;
#pragma unroll
                        for (int j = 0; j < 4; ++j) { o[2 * j] += bflo(pr[j]); o[2 * j + 1] += bfhi(pr[j]); } }
                    u32x4 w; w[0] = pk2(o[0], o[1]); w[1] = pk2(o[2], o[3]); w[2] = pk2(o[4], o[5]); w[3] = pk2(o[6], o[7]);
                    *(u32x4*)dp = w; } }
    } };
struct EpiRes { static constexpr bool PERM = false, AFTER_DRAIN = false, CHAIN = false; float* C; const float* R;
    DI void operator()(const pg8::f32x4 (&acc)[2][2][4][2], const pg8::Unit& u, int wr, int wc, int fr, int fq) const {
        const int row0 = u.pm * 256 + wr * 64 + fr, col0 = u.pn * 256 + wc * 32 + 4 * fq;
#pragma unroll
        for (int ai = 0; ai < 2; ++ai)
#pragma unroll
            for (int m = 0; m < 4; ++m) { const size_t ro = (size_t)(row0 + ai * 128 + m * 16) * DM + col0;
#pragma unroll
                for (int bj = 0; bj < 2; ++bj)
#pragma unroll
                    for (int n = 0; n < 2; ++n) { const pg8::f32x4 rv = *(const pg8::f32x4*)(R + ro + bj * 128 + n * 16); *(pg8::f32x4*)(C + ro + bj * 128 + n * 16) = acc[ai][bj][m][n] + rv; } }
    } };
struct EpiGU { static constexpr bool PERM = true, AFTER_DRAIN = false, CHAIN = false; bf16_t* ACT;
    DI void operator()(const pg8::f32x4 (&acc)[2][2][4][2], const pg8::Unit& u, int wr, int wc, int fr, int fq) const {
        const int row0 = u.pm * 256 + wr * 64 + fr, col0 = u.pn * 128 + wc * 32 + 8 * fq;
#pragma unroll
        for (int ai = 0; ai < 2; ++ai)
#pragma unroll
            for (int m = 0; m < 4; ++m) { const pg8::f32x4 g0 = acc[ai][0][m][0], g1 = acc[ai][0][m][1], u0 = acc[ai][1][m][0], u1 = acc[ai][1][m][1];
                u32x4 w; w[0] = pk2(silu(g0[0]) * u0[0], silu(g0[1]) * u0[1]); w[1] = pk2(silu(g0[2]) * u0[2], silu(g0[3]) * u0[3]);
                w[2] = pk2(silu(g1[0]) * u1[0], silu(g1[1]) * u1[1]); w[3] = pk2(silu(g1[2]) * u1[2], silu(g1[3]) * u1[3]);
                *(u32x4*)(ACT + (size_t)(row0 + ai * 128 + m * 16) * DFF + col0) = w; }
    } };
struct BrOrder : pg8::StaticOrder {
    __device__ bool next(int i, pg8::Unit& u) const { if (!pg8::StaticOrder::next(i >> 1, u)) return false; if (i & 1) { u.pm += 32; u.pn += 8; } return true; }
};
struct EpiMix2 { static constexpr bool PERM = true, AFTER_DRAIN = false, CHAIN = true; bf16_t* MIX; const bf16_t* P;
    DI bool first(const pg8::Unit& u) const { return u.pm < 32; }
    DI void mid(pg8::f32x4 (&acc)[2][2][4][2], const pg8::Unit& u, int wr, int wc, int fr, int fq) const {
        const int row0 = u.pm * 256 + wr * 64 + fr, col0 = u.pn * 256 + wc * 32 + 8 * fq;
#pragma unroll
        for (int ai = 0; ai < 2; ++ai)
#pragma unroll
            for (int m = 0; m < 4; ++m) { const size_t ro = (size_t)(row0 + ai * 128 + m * 16) * NP + col0;
#pragma unroll
                for (int bj = 0; bj < 2; ++bj) { const u32x4 ga = *(const u32x4*)(P + ro + C_MA + bj * 128), gb = *(const u32x4*)(P + ro + C_MB + bj * 128);
#pragma unroll
                    for (int j = 0; j < 4; ++j) { const float r0 = (1.0f + __expf(-bflo(gb[j]))) * __builtin_amdgcn_rcpf(1.0f + __expf(-bflo(ga[j]))), r1 = (1.0f + __expf(-bfhi(gb[j]))) * __builtin_amdgcn_rcpf(1.0f + __expf(-bfhi(ga[j])));
                        acc[ai][bj][m][j >> 1][(j & 1) * 2] *= r0; acc[ai][bj][m][j >> 1][(j & 1) * 2 + 1] *= r1; } } }
    }
    DI void operator()(const pg8::f32x4 (&acc)[2][2][4][2], const pg8::Unit& u, int wr, int wc, int fr, int fq) const {
        const int row0 = (u.pm - 32) * 256 + wr * 64 + fr, col0 = (u.pn - 8) * 256 + wc * 32 + 8 * fq;
#pragma unroll
        for (int ai = 0; ai < 2; ++ai)
#pragma unroll
            for (int m = 0; m < 4; ++m) { const int row = row0 + ai * 128 + m * 16;
#pragma unroll
                for (int bj = 0; bj < 2; ++bj) { const pg8::f32x4 v0 = acc[ai][bj][m][0], v1 = acc[ai][bj][m][1];
                    const u32x4 gb = *(const u32x4*)(P + (size_t)row * NP + C_MB + col0 + bj * 128);
                    u32x4 w; w[0] = pk2(v0[0] * sigm(bflo(gb[0])), v0[1] * sigm(bfhi(gb[0]))); w[1] = pk2(v0[2] * sigm(bflo(gb[1])), v0[3] * sigm(bfhi(gb[1])));
                    w[2] = pk2(v1[0] * sigm(bflo(gb[2])), v1[1] * sigm(bfhi(gb[2]))); w[3] = pk2(v1[2] * sigm(bflo(gb[3])), v1[3] * sigm(bfhi(gb[3])));
                    *(u32x4*)(MIX + (size_t)row * DM + col0 + bj * 128) = w; } }
    } };
struct HalfOrder : pg8::StaticOrder {
    int n0;
    __device__ void init2(int M, int N, int G_, int c_) { pg8::StaticOrder::init(M / 2, N, G_, c_); n0 = c_ < nwg ? (nwg - c_ + G_ - 1) / G_ : 0; }
    __device__ bool next(int i, pg8::Unit& u) const { if (i >= 2 * n0) return false; const int h = i >= n0 ? 1 : 0; pg8::StaticOrder::next(i - h * n0, u); u.pm += h * nM; return true; }
};
template <class Epi> DI void run_gemm_half(LAS unsigned char* lds, const bf16_t* A, const bf16_t* Bt, int M, int N, int K, const Epi& E) {
    pg8::Gemm g{A, Bt, M, N, K}; HalfOrder S; S.init2(M, N, (int)gridDim.x, (int)blockIdx.x);
    pg8::gemm_phase<Epi, HalfOrder, false>((PG8_LAS unsigned char*)lds, g, S, E, nullptr);
    __syncthreads();
}
template <class Epi> DI void run_gemm(LAS unsigned char* lds, const bf16_t* A, const bf16_t* Bt, int M, int N, int K, const Epi& E) {
    pg8::Gemm g{A, Bt, M, N, K}; pg8::StaticOrder S; S.init(M, N, (int)gridDim.x, (int)blockIdx.x);
    pg8::gemm_phase<Epi, pg8::StaticOrder, false>((PG8_LAS unsigned char*)lds, g, S, E, nullptr);
    __syncthreads();
}

DI void qk_norm_item(bf16_t* PROJ, const float* qg, const float* kg, int item, int tid) {
    asm volatile("" : "+v"(tid));
    const int w = tid >> 6, lane = tid & 63, sub = lane & 15, vq = lane >> 4;
#pragma unroll 1
    for (int tt = 0; tt < 2; ++tt) {
        const int tok = item * 16 + w * 2 + tt;
#pragma unroll 1
        for (int it = 0; it < 6; ++it) {
            const int vi = it * 4 + vq;
            int col; const float* gn; float sc = 1.0f;
            if (vi < 16) { col = vi * 128; gn = qg; sc = QSCALE; }
            else if (vi < 20) { col = C_KV + (8 + (vi - 16)) * 128; gn = kg + 128; }
            else { col = C_KV + (16 + (vi - 20)) * 128; gn = kg + 256; }
            bf16_t* p = PROJ + (size_t)tok * NP + col + sub * 8;
            const u32x4 raw = *(const u32x4*)p; float v[8];
#pragma unroll
            for (int j = 0; j < 4; ++j) { v[2 * j] = bflo(raw[j]); v[2 * j + 1] = bfhi(raw[j]); }
            float ss = 0.f;
#pragma unroll
            for (int j = 0; j < 8; ++j) ss += v[j] * v[j];
            ss = sum16(ss);
            const float rs = rsqrtf(ss * (1.0f / 128.0f) + EPS) * sc;
            const f32x4 g0 = *(const f32x4*)(gn + sub * 8), g1 = *(const f32x4*)(gn + sub * 8 + 4);
            u32x4 o; o[0] = pk2(v[0] * rs * g0[0], v[1] * rs * g0[1]); o[1] = pk2(v[2] * rs * g0[2], v[3] * rs * g0[3]);
            o[2] = pk2(v[4] * rs * g1[0], v[5] * rs * g1[1]); o[3] = pk2(v[6] * rs * g1[2], v[7] * rs * g1[3]);
            *(u32x4*)p = o;
        }
    }
}
DI void cmp_item(LAS unsigned char* L, const bf16_t* PROJ, const bf16_t* WCT, const float* cmpc, const float* kgain, bf16_t* KC, bf16_t* VCT, int item, int tid) {
    asm volatile("" : "+v"(tid));
    const int rq = item & 3, kv = (item >> 2) & 1, g = (item >> 3) & 3, bl = item >> 5;
    const int w = tid >> 6, lane = tid & 63, c = lane & 31, hf = lane >> 5, mt = w & 1, et = w >> 1;
    int n = rq * 64 + mt * 32 + c; if (n > 254) n = 254;
    const bf16_t* ap = PROJ + (size_t)(bl * SEQ + 16 * n) * NP + C_KV + (kv * 4 + g) * 128 + hf * 8;
    const bf16_t* bp = WCT + (size_t)kv * 128 * 4096 + (size_t)(et * 32 + c) * 4096 + hf * 8;
    f32x16 acc = zero16();
    bf16x8 a0[8], b0[8], a1[8], b1[8];
#pragma unroll
    for (int ds = 0; ds < 8; ++ds) { a0[ds] = *(const bf16x8*)(ap + ds * 16); b0[ds] = *(const bf16x8*)(bp + ds * 16); }
#pragma unroll 1
    for (int l = 0; l < 32; l += 2) {
#pragma unroll
        for (int ds = 0; ds < 8; ++ds) { a1[ds] = *(const bf16x8*)(ap + (size_t)(l + 1) * NP + ds * 16); b1[ds] = *(const bf16x8*)(bp + (l + 1) * 128 + ds * 16); }
        asm volatile("" ::: "memory");
#pragma unroll
        for (int ds = 0; ds < 8; ++ds) acc = mfma32(a0[ds], b0[ds], acc);
        if (l + 2 < 32) {
#pragma unroll
            for (int ds = 0; ds < 8; ++ds) { a0[ds] = *(const bf16x8*)(ap + (size_t)(l + 2) * NP + ds * 16); b0[ds] = *(const bf16x8*)(bp + (l + 2) * 128 + ds * 16); }
        }
        asm volatile("" ::: "memory");
#pragma unroll
        for (int ds = 0; ds < 8; ++ds) acc = mfma32(a1[ds], b1[ds], acc);
    }
    LAS float* st = (LAS float*)L;
    const int e = et * 32 + c; float cc = 0.f;
#pragma unroll
    for (int i = 0; i < 8; ++i) cc += cmpc[(kv * 8 + i) * 128 + e];
#pragma unroll
    for (int i = 0; i < 16; ++i) st[(mt * 32 + crow(i, hf)) * 129 + e] = acc[i] + cc;
    __syncthreads();
    if (kv == 0) {
#pragma unroll 1
        for (int rr = 0; rr < 8; ++rr) { const int row = w * 8 + rr, nn = rq * 64 + row;
            const float v0 = st[row * 129 + lane], v1 = st[row * 129 + lane + 64];
            const float ss = wsum(v0 * v0 + v1 * v1), rs = rsqrtf(ss * (1.0f / 128.0f) + EPS);
            bf16_t* d = KC + ((size_t)(bl * 256 + nn) * 4 + g) * 128;
            d[lane] = f2bf(v0 * rs * kgain[lane]); d[lane + 64] = f2bf(v1 * rs * kgain[lane + 64]); }
    } else {
        const int ee = tid >> 2, nc = (tid & 3) * 16; u32x4 o[2];
#pragma unroll
        for (int j = 0; j < 8; ++j) { const int r0 = nc + 2 * j; float a = st[r0 * 129 + ee], b = st[(r0 + 1) * 129 + ee];
            if (rq * 64 + r0 >= 255) a = 0.f; if (rq * 64 + r0 + 1 >= 255) b = 0.f; o[j >> 2][j & 3] = pk2(a, b); }
        bf16_t* d = VCT + ((size_t)(bl * 4 + g) * 128 + ee) * 256 + rq * 64 + nc;
        *(u32x4*)d = o[0]; *(u32x4*)(d + 8) = o[1];
    }
    __syncthreads();
}
DI void vt_item(LAS unsigned char* L, const bf16_t* PROJ, bf16_t* VT, int item, int tid) {
    asm volatile("" : "+v"(tid));
    const int tb = item & 63, g = (item >> 6) & 3, bl = (item >> 8) & 1, br = item >> 9;
    const bf16_t* src = PROJ + (size_t)(bl * SEQ + tb * 64) * NP + C_KV + (((br + 1) * 2 + 1) * 4 + g) * 128;
#pragma unroll
    for (int i = 0; i < 2; ++i) { const int c = tid + 512 * i, tok = c >> 4, part = c & 15;
        const u32x4 v = *(const u32x4*)(src + (size_t)tok * NP + part * 8);
        LAS u32x2* d = (LAS u32x2*)(L + tok * 264 + part * 16); d[0] = (u32x2){v[0], v[1]}; d[1] = (u32x2){v[2], v[3]}; }
    __syncthreads();
    const int d = tid >> 2, tc = (tid & 3) * 16; u32x4 o[2];
#pragma unroll
    for (int j = 0; j < 8; ++j) { const unsigned a = *(LAS bf16_t*)(L + (tc + 2 * j) * 264 + d * 2), b = *(LAS bf16_t*)(L + (tc + 2 * j + 1) * 264 + d * 2); o[j >> 2][j & 3] = a | (b << 16); }
    bf16_t* dst = VT + ((size_t)((br * 2 + bl) * 4 + g) * 128 + d) * SEQ + tb * 64 + tc;
    *(u32x4*)dst = o[0]; *(u32x4*)(dst + 8) = o[1];
    __syncthreads();
}
constexpr int GP_QB = 0, GP_KB = 17408, GP_KGT = 34816, GP_KBGT = 53248, GP_VBT = 71680, GP_LM = 90112, GP_TB = 107520, GP_QKS = 116736, GP_GC = 125952, GP_BETA = 126208;
DI void ld_lrows(unsigned addr, f32x4 (&lo)[8], f32x4 (&hi)[8]) {
    asm volatile("ds_read_b128 %0, %16\n\tds_read_b128 %8, %16 offset:16\n\tds_read_b128 %1, %16 offset:272\n\tds_read_b128 %9, %16 offset:288\n\t"
                 "ds_read_b128 %2, %16 offset:544\n\tds_read_b128 %10, %16 offset:560\n\tds_read_b128 %3, %16 offset:816\n\tds_read_b128 %11, %16 offset:832\n\t"
                 "ds_read_b128 %4, %16 offset:1088\n\tds_read_b128 %12, %16 offset:1104\n\tds_read_b128 %5, %16 offset:1360\n\tds_read_b128 %13, %16 offset:1376\n\t"
                 "ds_read_b128 %6, %16 offset:1632\n\tds_read_b128 %14, %16 offset:1648\n\tds_read_b128 %7, %16 offset:1904\n\tds_read_b128 %15, %16 offset:1920\n\t"
                 "s_waitcnt lgkmcnt(0)"
                 : "=&v"(lo[0]), "=&v"(lo[1]), "=&v"(lo[2]), "=&v"(lo[3]), "=&v"(lo[4]), "=&v"(lo[5]), "=&v"(lo[6]), "=&v"(lo[7]),
                   "=&v"(hi[0]), "=&v"(hi[1]), "=&v"(hi[2]), "=&v"(hi[3]), "=&v"(hi[4]), "=&v"(hi[5]), "=&v"(hi[6]), "=&v"(hi[7])
                 : "v"(addr) : "memory");
}
DI void gdn_prep_item(LAS unsigned char* L, const bf16_t* PROJ, const float* convw, const float* a_log, const float* dt_bias,
                      bf16_t* GQG, bf16_t* GKGT, bf16_t* GW, bf16_t* GUT, bf16_t* GQK, float* GEXP, int unit, int tid) {
    asm volatile("" : "+v"(tid));
    const int h = unit & 15, n = (unit >> 4) & 63, bl = unit >> 10;
    const int w = tid >> 6, lane = tid & 63, c = lane & 31, hf = lane >> 5;
    LAS float* gcs = (LAS float*)(L + GP_GC); LAS float* betas = (LAS float*)(L + GP_BETA);
    const bf16_t* base = PROJ + (size_t)(bl * SEQ) * NP;
    const int sl0 = n * 64 + w * 8;
    unsigned raw[3][11]; float cw[3][4][2];
#pragma unroll
        for (int wh = 0; wh < 3; ++wh) { const int col = C_GQ + wh * 2048 + h * 128 + 2 * lane;
#pragma unroll
            for (int r = 0; r < 11; ++r) { const int sl = sl0 - 3 + r; raw[wh][r] = (sl >= 0) ? *(const unsigned*)(base + (size_t)sl * NP + col) : 0u; }
#pragma unroll
            for (int i = 0; i < 4; ++i) { const f2_t cv = *(const f2_t*)(convw + (size_t)i * 6144 + wh * 2048 + h * 128 + 2 * lane); cw[wh][i][0] = cv[0]; cw[wh][i][1] = cv[1]; } }
    if (w == 0) {
        const size_t tok = (size_t)(n * 64 + lane);
        const float av = bf2f(base[tok * NP + C_A + h]), bv = bf2f(base[tok * NP + C_B + h]);
        const float xs = av + dt_bias[h]; const float sp = xs > 15.f ? xs : __logf(1.0f + __expf(xs));
        float gv = -__expf(a_log[h]) * sp;
#pragma unroll
        for (int o = 1; o < 64; o <<= 1) { const float t = __shfl_up(gv, o); if (lane >= o) gv += t; }
        gcs[lane] = gv; betas[lane] = sigm(bv);
    }
    __syncthreads();
    const float glast = gcs[63];
    {
        float pkg[2], pkbg[2], pvb[2];
#pragma unroll
        for (int tt = 0; tt < 8; ++tt) {
            float y[3][2];
#pragma unroll
            for (int wh = 0; wh < 3; ++wh) { float a0 = 0.f, a1 = 0.f;
#pragma unroll
                for (int i = 0; i < 4; ++i) { a0 += cw[wh][i][0] * bflo(raw[wh][tt + i]); a1 += cw[wh][i][1] * bfhi(raw[wh][tt + i]); }
                y[wh][0] = silu(a0); y[wh][1] = silu(a1); }
            const float ssq = wsum(y[0][0] * y[0][0] + y[0][1] * y[0][1]), ssk = wsum(y[1][0] * y[1][0] + y[1][1] * y[1][1]);
            const float qs = rsqrtf(ssq + EPS) * 0.08838834764831845f, ks = rsqrtf(ssk + EPS);
            const int t = w * 8 + tt; const float gct = gcs[t], bt = betas[t], eg = __expf(gct), ek = __expf(glast - gct);
            const float q0 = y[0][0] * qs, q1 = y[0][1] * qs, k0 = y[1][0] * ks, k1 = y[1][1] * ks;
            *(LAS unsigned*)(L + GP_QB + (t * 136 + 2 * lane) * 2) = pk2(q0, q1);
            *(LAS unsigned*)(L + GP_KB + (t * 136 + 2 * lane) * 2) = pk2(k0, k1);
            *(unsigned*)(GQG + (size_t)unit * 8192 + t * 128 + 2 * lane) = pk2(q0 * eg, q1 * eg);
            const float kg0 = k0 * ek, kg1 = k1 * ek, kb0 = k0 * bt * eg, kb1 = k1 * bt * eg, vb0 = y[2][0] * bt, vb1 = y[2][1] * bt;
            if (tt & 1) {
                *(LAS unsigned*)(L + GP_KGT + ((2 * lane) * 72 + t - 1) * 2) = pk2(pkg[0], kg0); *(LAS unsigned*)(L + GP_KGT + ((2 * lane + 1) * 72 + t - 1) * 2) = pk2(pkg[1], kg1);
                *(LAS unsigned*)(L + GP_KBGT + ((2 * lane) * 72 + t - 1) * 2) = pk2(pkbg[0], kb0); *(LAS unsigned*)(L + GP_KBGT + ((2 * lane + 1) * 72 + t - 1) * 2) = pk2(pkbg[1], kb1);
                *(LAS unsigned*)(L + GP_VBT + ((2 * lane) * 72 + t - 1) * 2) = pk2(pvb[0], vb0); *(LAS unsigned*)(L + GP_VBT + ((2 * lane + 1) * 72 + t - 1) * 2) = pk2(pvb[1], vb1);
            } else { pkg[0] = kg0; pkg[1] = kg1; pkbg[0] = kb0; pkbg[1] = kb1; pvb[0] = vb0; pvb[1] = vb1; }
        }
    }
    __syncthreads();
    {
        const int which = w >> 2, ti = (w >> 1) & 1, tj = w & 1;
        f32x16 acc = zero16();
        if (ti >= tj) {
#pragma unroll
            for (int s = 0; s < 8; ++s) {
                const bf16x8 a = *(const LAS bf16x8*)(L + (which ? GP_QB : GP_KB) + ((ti * 32 + c) * 136 + 16 * s + 8 * hf) * 2);
                const bf16x8 b = *(const LAS bf16x8*)(L + GP_KB + ((tj * 32 + c) * 136 + 16 * s + 8 * hf) * 2);
                acc = mfma32(a, b, acc);
            }
        }
        const int j = tj * 32 + c; const float gj = gcs[j];
#pragma unroll
        for (int r = 0; r < 16; ++r) { const int i = ti * 32 + crow(r, hf); const float gi = gcs[i];
            if (which == 0) { const float v = (i > j) ? betas[i] * acc[r] * __expf(gi - gj) : 0.f; *(LAS float*)(L + GP_LM + (i * 68 + (j & 7) * 8 + (j >> 3)) * 4) = v; }
            else { const float v = (i >= j) ? acc[r] * __expf(gi - gj) : 0.f; *(LAS bf16_t*)(L + GP_QKS + (i * 72 + j) * 2) = f2bf(v); } }
    }
    __syncthreads();
    {
        const int mp = lane & 7, j = 8 * w + (lane >> 3); float xr[8];
#pragma unroll
        for (int k = 0; k < 8; ++k) xr[k] = 0.f;
#pragma unroll
        for (int i8 = 0; i8 < 8; ++i8) {
            f32x4 lo[8], hi[8];
            ld_lrows((unsigned)(unsigned long)(L + GP_LM + ((8 * i8) * 68 + mp * 8) * 4), lo, hi);
#pragma unroll
            for (int r = 0; r < 8; ++r) { const int i = 8 * i8 + r; float a = 0.f;
#pragma unroll
                for (int k = 0; k < 8; ++k) if (8 * k < i) a += (k < 4 ? lo[r][k & 3] : hi[r][k & 3]) * xr[k];
                a = sum8(a);
                const float x = ((i == j) ? 1.f : 0.f) - a;
                if (mp == r) xr[i8] = x; }
        }
#pragma unroll
        for (int k = 0; k < 8; ++k) *(LAS bf16_t*)(L + GP_TB + ((8 * k + mp) * 72 + j) * 2) = f2bf(xr[k]);
    }
    __syncthreads();
    {
        const int mt = w & 1, dt = w >> 1; f32x16 au = zero16(), aw = zero16();
#pragma unroll
        for (int s = 0; s < 4; ++s) {
            const bf16x8 tb = *(const LAS bf16x8*)(L + GP_TB + ((mt * 32 + c) * 72 + 16 * s + 8 * hf) * 2);
            const bf16x8 vb = *(const LAS bf16x8*)(L + GP_VBT + ((dt * 32 + c) * 72 + 16 * s + 8 * hf) * 2);
            const bf16x8 kb = *(const LAS bf16x8*)(L + GP_KBGT + ((dt * 32 + c) * 72 + 16 * s + 8 * hf) * 2);
            au = mfma32(tb, vb, au); aw = mfma32(kb, tb, aw);
        }
#pragma unroll
        for (int q = 0; q < 4; ++q) {
            *(u32x2*)(GUT + (size_t)unit * 8192 + (dt * 32 + c) * 64 + mt * 32 + 8 * q + 4 * hf) = (u32x2){pk2(au[4 * q], au[4 * q + 1]), pk2(au[4 * q + 2], au[4 * q + 3])};
            *(u32x2*)(GW + (size_t)unit * 8192 + (mt * 32 + c) * 128 + dt * 32 + 8 * q + 4 * hf) = (u32x2){pk2(aw[4 * q], aw[4 * q + 1]), pk2(aw[4 * q + 2], aw[4 * q + 3])};
        }
#pragma unroll
        for (int i = 0; i < 2; ++i) { const int cc = tid + 512 * i, d = cc >> 3, part = cc & 7;
            *(u32x4*)(GKGT + (size_t)unit * 8192 + d * 64 + part * 8) = *(const LAS u32x4*)(L + GP_KGT + (d * 72 + part * 8) * 2); }
        { const int r = tid >> 3, part = tid & 7; *(u32x4*)(GQK + (size_t)unit * 4096 + r * 64 + part * 8) = *(const LAS u32x4*)(L + GP_QKS + (r * 72 + part * 8) * 2); }
        if (tid == 0) GEXP[unit] = __expf(glast);
    }
    __syncthreads();
}

DI void cmp_attn_item(LAS unsigned char* L, const bf16_t* PROJ, const bf16_t* KC, const bf16_t* VCT, bf16_t* OA, unsigned* SEL, const float* moff, int item, int tid) {
    asm volatile("" : "+v"(tid));
    const int qb = (item & 256) ? (item & 63) : 63 - (item & 63), g = (item >> 6) & 3, bl = (item >> 8) & 1 ? 1 : 0;
    const int w = tid >> 6, lane = tid & 63, c = lane & 31, hf = lane >> 5;
    const int tl = w * 8 + (c >> 2), r = c & 3, t = qb * 64 + tl, tok = bl * SEQ + t, h = g * 4 + r;
    bf16x8 qf[8];
#pragma unroll
    for (int s = 0; s < 8; ++s) qf[s] = *(const bf16x8*)(PROJ + (size_t)tok * NP + h * 128 + 16 * s + 8 * hf);
    const int ntile = (4 * qb + 34) >> 5, nvalid = t >= 31 ? ((t - 31) >> 4) + 1 : 0, lim = nvalid - 4 * hf;
    const bf16_t* kcb = KC + ((size_t)(bl * 256 + c) * 4 + g) * 128 + 8 * hf;
    const bf16_t* vcb = VCT + ((size_t)(bl * 4 + g) * 128 + c) * 256 + 4 * hf;
    const float m = moff[0];
    LAS float* Lv = (LAS float*)L + tid; float lsum = 0.f, Elast = 0.f; f32x16 O[4];
#pragma unroll
    for (int d = 0; d < 4; ++d) O[d] = zero16();
#pragma unroll
    for (int tau = 0; tau < 8; ++tau) {
        if (tau < ntile) {
            f32x16 acc = zero16();
#pragma unroll
            for (int s = 0; s < 8; ++s) acc = mfma32(*(const bf16x8*)(kcb + (size_t)tau * 32 * 512 + 16 * s), qf[s], acc);
#pragma unroll
            for (int i = 0; i < 16; ++i) { const float p = (32 * tau + crow(i, 0) < lim) ? __builtin_amdgcn_exp2f(acc[i] - m) : 0.f; acc[i] = p; lsum += p; }
#pragma unroll
            for (int a = 0; a < 4; ++a) { const float Wq = acc[4 * a] + acc[4 * a + 1] + acc[4 * a + 2] + 0.5f * acc[4 * a + 3], Eq = 0.5f * acc[4 * a + 3];
                const float ep_same = __shfl_xor(Eq, 32), ep_prev = __shfl_xor(Elast, 32);
                Lv[(tau * 4 + a) * 512] = Wq + (hf ? ep_same : ep_prev); Elast = Eq; }
#pragma unroll
            for (int s2 = 0; s2 < 2; ++s2) { const bf16x8 pf = pack8(acc, s2);
#pragma unroll
                for (int d = 0; d < 4; ++d) { const bf16_t* vp = vcb + (size_t)d * 32 * 256 + 32 * tau + 16 * s2;
                    O[d] = mfma32(cat8(*(const u32x2*)vp, *(const u32x2*)(vp + 8)), pf, O[d]); } }
        } else {
#pragma unroll
            for (int a = 0; a < 4; ++a) Lv[(tau * 4 + a) * 512] = 0.f;
        }
    }
    lsum += __shfl_xor(lsum, 32);
    const float inv = lsum > 0.f ? 1.0f / lsum : 0.f;
    {
        const float g0 = sigm(bf2f(PROJ[(size_t)tok * NP + C_GATE + h * 3 + 0])) * inv;
#pragma unroll
        for (int d = 0; d < 4; ++d)
#pragma unroll
            for (int q = 0; q < 4; ++q) *(u32x2*)(OA + (size_t)tok * DM + h * 128 + d * 32 + 8 * q + 4 * hf) = (u32x2){pk2(O[d][4 * q] * g0, O[d][4 * q + 1] * g0), pk2(O[d][4 * q + 2] * g0, O[d][4 * q + 3] * g0)};
    }
    LAS float* SC = (LAS float*)(L + 65536) + w * 520;
#pragma unroll
    for (int q = 0; q < 32; ++q) {
        float v = Lv[q * 512] * inv; v += dppf<0xB1>(v); v += dppf<0x4E>(v);
        const int j = 2 * q + hf; const bool forced = (j == 0) | (j == qb) | (j == qb - 1), causal = j <= qb;
        if (r == 0) SC[(c >> 2) * 65 + j] = forced ? 1e4f : (causal ? v : -1e4f);
    }
    asm volatile("s_waitcnt lgkmcnt(0)" ::: "memory");
    {
        const int tk = lane >> 3, jb = (lane & 7) * 8; float sv[8]; int cnt[8];
#pragma unroll
        for (int e = 0; e < 8; ++e) { sv[e] = SC[tk * 65 + jb + e]; cnt[e] = 0; }
#pragma unroll 4
        for (int j2 = 0; j2 < 64; ++j2) { const float v = SC[tk * 65 + j2];
#pragma unroll
            for (int e = 0; e < 8; ++e) cnt[e] += ((v > sv[e]) || (v == sv[e] && j2 < jb + e)) ? 1 : 0; }
        unsigned bits = 0u;
#pragma unroll
        for (int e = 0; e < 8; ++e) bits |= (cnt[e] < 16 && jb + e <= qb) ? (1u << e) : 0u;
        unsigned lo = (lane & 4) ? 0u : (bits << (jb & 31)), hi = (lane & 4) ? (bits << (jb & 31)) : 0u;
        lo |= __shfl_xor(lo, 1); hi |= __shfl_xor(hi, 1); lo |= __shfl_xor(lo, 2); hi |= __shfl_xor(hi, 2); lo |= __shfl_xor(lo, 4); hi |= __shfl_xor(hi, 4);
        if ((lane & 7) == 0) *(u32x2*)(SEL + ((size_t)(bl * SEQ + qb * 64 + w * 8 + tk) * 4 + g) * 2) = (u32x2){lo, hi};
    }
    asm volatile("s_waitcnt lgkmcnt(0)" ::: "memory");
}

constexpr int AT_K = 0, AT_V = 34816, AT_MISC = 71680;
DI void at_load(const bf16_t* Kg, const bf16_t* VTg, int j, int tid, u32x4 (&kr)[2], u32x4 (&vr)[2]) {
    const char* kb = (const char*)(Kg + (size_t)j * 64 * NP); const char* vb = (const char*)(VTg + j * 64);
#pragma unroll
    for (int i = 0; i < 2; ++i) { const int cc = tid + 512 * i; unsigned ko = (unsigned)(((cc >> 4) * NP + (cc & 15) * 8) * 2), vo = (unsigned)(((cc >> 3) * SEQ + (cc & 7) * 8) * 2);
        asm volatile("" : "+v"(ko), "+v"(vo));
        kr[i] = *(const u32x4*)(kb + ko); vr[i] = *(const u32x4*)(vb + vo); }
}
DI void at_store(LAS unsigned char* L, int buf, int tid, const u32x4 (&kr)[2], const u32x4 (&vr)[2]) {
#pragma unroll
    for (int i = 0; i < 2; ++i) { const int cc = tid + 512 * i, part = cc & 7;
        *(LAS u32x4*)(L + AT_K + buf * 17408 + (cc >> 4) * 272 + (cc & 15) * 16) = kr[i];
        LAS unsigned char* d = L + AT_V + buf * 18432 + (cc >> 3) * 144 + (part >> 1) * 32 + (part & 1) * 8;
        *(LAS u32x2*)d = (u32x2){vr[i][0], vr[i][1]}; *(LAS u32x2*)(d + 16) = (u32x2){vr[i][2], vr[i][3]}; }
}
DI int at_next(int j, int qb, u64 um) { for (++j; j <= qb; ++j) if ((um >> j) & 1ull) break; return j; }
DI void qk_chain(f32x16& sc, unsigned addr, const bf16x8 (&q)[8]) {
    bf16x8 k0, k1, k2, k3, k4, k5, k6, k7;
    asm volatile(
        "ds_read_b128 %1, %9\n\tds_read_b128 %2, %9 offset:32\n\tds_read_b128 %3, %9 offset:64\n\tds_read_b128 %4, %9 offset:96\n\t"
        "ds_read_b128 %5, %9 offset:128\n\tds_read_b128 %6, %9 offset:160\n\tds_read_b128 %7, %9 offset:192\n\tds_read_b128 %8, %9 offset:224\n\t"
        "s_waitcnt lgkmcnt(7)\n\tv_mfma_f32_32x32x16_bf16 %0, %1, %10, %0\n\t"
        "s_waitcnt lgkmcnt(6)\n\tv_mfma_f32_32x32x16_bf16 %0, %2, %11, %0\n\t"
        "s_waitcnt lgkmcnt(5)\n\tv_mfma_f32_32x32x16_bf16 %0, %3, %12, %0\n\t"
        "s_waitcnt lgkmcnt(4)\n\tv_mfma_f32_32x32x16_bf16 %0, %4, %13, %0\n\t"
        "s_waitcnt lgkmcnt(3)\n\tv_mfma_f32_32x32x16_bf16 %0, %5, %14, %0\n\t"
        "s_waitcnt lgkmcnt(2)\n\tv_mfma_f32_32x32x16_bf16 %0, %6, %15, %0\n\t"
        "s_waitcnt lgkmcnt(1)\n\tv_mfma_f32_32x32x16_bf16 %0, %7, %16, %0\n\t"
        "s_waitcnt lgkmcnt(0)\n\tv_mfma_f32_32x32x16_bf16 %0, %8, %17, %0\n\t"
        "s_nop 15\n\ts_nop 3"
        : "+v"(sc), "=&v"(k0), "=&v"(k1), "=&v"(k2), "=&v"(k3), "=&v"(k4), "=&v"(k5), "=&v"(k6), "=&v"(k7)
        : "v"(addr), "v"(q[0]), "v"(q[1]), "v"(q[2]), "v"(q[3]), "v"(q[4]), "v"(q[5]), "v"(q[6]), "v"(q[7])
        : "memory");
}
DI void pv_chain(f32x16& o0, f32x16& o1, f32x16& o2, f32x16& o3, unsigned addr, bf16x8 p0, bf16x8 p1) {
    bf16x8 v0, v1, v2, v3, v4, v5, v6, v7;
    asm volatile(
        "ds_read_b128 %4, %12\n\tds_read_b128 %5, %12 offset:4608\n\tds_read_b128 %6, %12 offset:9216\n\tds_read_b128 %7, %12 offset:13824\n\t"
        "ds_read_b128 %8, %12 offset:32\n\tds_read_b128 %9, %12 offset:4640\n\tds_read_b128 %10, %12 offset:9248\n\tds_read_b128 %11, %12 offset:13856\n\t"
        "s_waitcnt lgkmcnt(7)\n\tv_mfma_f32_32x32x16_bf16 %0, %4, %13, %0\n\t"
        "s_waitcnt lgkmcnt(6)\n\tv_mfma_f32_32x32x16_bf16 %1, %5, %13, %1\n\t"
        "s_waitcnt lgkmcnt(5)\n\tv_mfma_f32_32x32x16_bf16 %2, %6, %13, %2\n\t"
        "s_waitcnt lgkmcnt(4)\n\tv_mfma_f32_32x32x16_bf16 %3, %7, %13, %3\n\t"
        "s_waitcnt lgkmcnt(3)\n\tv_mfma_f32_32x32x16_bf16 %0, %8, %14, %0\n\t"
        "s_waitcnt lgkmcnt(2)\n\tv_mfma_f32_32x32x16_bf16 %1, %9, %14, %1\n\t"
        "s_waitcnt lgkmcnt(1)\n\tv_mfma_f32_32x32x16_bf16 %2, %10, %14, %2\n\t"
        "s_waitcnt lgkmcnt(0)\n\tv_mfma_f32_32x32x16_bf16 %3, %11, %14, %3\n\t"
        "s_nop 15\n\ts_nop 3"
        : "+v"(o0), "+v"(o1), "+v"(o2), "+v"(o3), "=&v"(v0), "=&v"(v1), "=&v"(v2), "=&v"(v3), "=&v"(v4), "=&v"(v5), "=&v"(v6), "=&v"(v7)
        : "v"(addr), "v"(p0), "v"(p1)
        : "memory");
}
template <int MODE> DI void attn_pass(LAS unsigned char* L, const bf16_t* Kg, const bf16_t* VTg, int qb, u64 selm, u64 um, int tl64, const bf16x8 (&qf)[8],
                                      f32x16 (&O)[4], float& lsum, float moff, int tid) {
    const int lane = tid & 63, c = lane & 31, hf = lane >> 5;
    lsum = 0.f;
#pragma unroll
    for (int d = 0; d < 4; ++d) O[d] = zero16();
    int j = at_next((MODE ? (qb > 8 ? qb - 8 : 0) : 0) - 1, qb, um), buf = 0;
    u32x4 kr[2], vr[2];
    if (j <= qb) { at_load(Kg, VTg, j, tid, kr, vr); at_store(L, 0, tid, kr, vr); }
    __syncthreads();
    while (j <= qb) {
        const int jn = at_next(j, qb, um);
        if (jn <= qb) at_load(Kg, VTg, jn, tid, kr, vr);
        {
            const LAS unsigned char* Kt = L + AT_K + buf * 17408; const LAS unsigned char* Vt = L + AT_V + buf * 18432;
            const bool diag = (j == qb), first = MODE ? (j == qb - 8) : false, selb = MODE ? true : (((selm >> j) & 1ull) != 0ull);
            const float init = selb ? -moff : -__builtin_inff();
            const int tlh = tl64 - 4 * hf;
            float ps = 0.f; bf16x8 pk[2][2];
#pragma unroll
            for (int kt = 0; kt < 2; ++kt) {
                f32x16 sc;
#pragma unroll
                for (int i = 0; i < 16; ++i) sc[i] = init;
                qk_chain(sc, (unsigned)(unsigned long)(Kt + (kt * 32 + c) * 272 + hf * 16), qf);
                if (diag || first) {
#pragma unroll
                    for (int i = 0; i < 16; ++i) { const int k0 = kt * 32 + crow(i, 0); sc[i] = (diag ? (k0 <= tlh) : (k0 > tlh)) ? sc[i] : -__builtin_inff(); }
                }
#pragma unroll
                for (int i = 0; i < 16; ++i) { const float p = __builtin_amdgcn_exp2f(sc[i]); sc[i] = p; ps += p; }
                pk[kt][0] = pack8(sc, 0); pk[kt][1] = pack8(sc, 1);
            }
            lsum += ps;
#pragma unroll
            for (int kt = 0; kt < 2; ++kt)
                pv_chain(O[0], O[1], O[2], O[3], (unsigned)(unsigned long)(Vt + c * 144 + kt * 64 + hf * 16), pk[kt][0], pk[kt][1]);
        }
        if (jn <= qb) at_store(L, buf ^ 1, tid, kr, vr);
        __syncthreads();
        buf ^= 1; j = jn;
    }
    lsum += __shfl_xor(lsum, 32);
}
DI void attn_item(LAS unsigned char* L, const bf16_t* PROJ, const bf16_t* VT, const unsigned* SEL, bf16_t* OA, const float* moff, int item, int tid) {
    asm volatile("" : "+v"(tid));
    const int qb = 63 - (item >> 3), g = item & 3, bl = (item >> 2) & 1;
    const int w = tid >> 6, lane = tid & 63, c = lane & 31, hf = lane >> 5;
    const int tl64 = w * 8 + (c >> 2), r = c & 3, tok = bl * SEQ + qb * 64 + tl64, h = g * 4 + r;
    bf16x8 qf[8];
#pragma unroll
    for (int s = 0; s < 8; ++s) qf[s] = *(const bf16x8*)(PROJ + (size_t)tok * NP + h * 128 + 16 * s + 8 * hf);
    const u32x2 sm = *(const u32x2*)(SEL + ((size_t)tok * 4 + g) * 2);
    const u64 selm = (u64)sm[0] | ((u64)sm[1] << 32);
    unsigned ulo = sm[0], uhi = sm[1];
#pragma unroll
    for (int o = 1; o < 64; o <<= 1) { ulo |= __shfl_xor(ulo, o); uhi |= __shfl_xor(uhi, o); }
    LAS unsigned* misc = (LAS unsigned*)(L + AT_MISC);
    if (lane == 0) { misc[2 * w] = ulo; misc[2 * w + 1] = uhi; }
    __syncthreads();
    unsigned alo = 0u, ahi = 0u;
#pragma unroll
    for (int i = 0; i < 8; ++i) { alo |= misc[2 * i]; ahi |= misc[2 * i + 1]; }
    const u64 um = (u64)alo | ((u64)ahi << 32);
    const float g1 = sigm(bf2f(PROJ[(size_t)tok * NP + C_GATE + h * 3 + 1])), g2 = sigm(bf2f(PROJ[(size_t)tok * NP + C_GATE + h * 3 + 2]));
    f32x16 O[4]; float lsum;
    const bf16_t* pb = PROJ + (size_t)(bl * SEQ) * NP;
#pragma unroll 1
    for (int pass = 0; pass < 2; ++pass) {
        if (pass == 0) attn_pass<0>(L, pb + C_KV + (8 + g) * 128, VT + (size_t)((0 * 2 + bl) * 4 + g) * 128 * SEQ, qb, selm, um, tl64, qf, O, lsum, moff[1], tid);
        else attn_pass<1>(L, pb + C_KV + (16 + g) * 128, VT + (size_t)((1 * 2 + bl) * 4 + g) * 128 * SEQ, qb, ~0ull, ~0ull, tl64, qf, O, lsum, moff[2], tid);
        const float f = lsum > 0.f ? (pass ? g2 : g1) / lsum : 0.f;
#pragma unroll
        for (int d = 0; d < 4; ++d)
#pragma unroll
            for (int q = 0; q < 4; ++q) { bf16_t* op = OA + (size_t)tok * DM + h * 128 + d * 32 + 8 * q + 4 * hf; const u32x2 pr = *(const u32x2*)op;
                const float a0 = bflo(pr[0]) + O[d][4 * q] * f, a1 = bfhi(pr[0]) + O[d][4 * q + 1] * f, a2 = bflo(pr[1]) + O[d][4 * q + 2] * f, a3 = bfhi(pr[1]) + O[d][4 * q + 3] * f;
                *(u32x2*)op = (u32x2){pk2(a0, a1), pk2(a2, a3)}; }
    }
}

struct ScanFrag { u32x2 wf[2][2][2], qg[2][2][2], qk[2][2], kg[4][2], u[2][4]; float eg; };
DI void scan_load(ScanFrag& F, const bf16_t* GQG, const bf16_t* GKGT, const bf16_t* GW, const bf16_t* GUT, const bf16_t* GQK, const float* GEXP, size_t unit, int sl, int ww, int c, int hf) {
#pragma unroll
    for (int mt = 0; mt < 2; ++mt) {
#pragma unroll
        for (int s = 0; s < 2; ++s) { const size_t o = unit * 8192 + (size_t)(mt * 32 + c) * 128 + 32 * ww + 16 * s + 4 * hf;
            F.wf[mt][s][0] = *(const u32x2*)(GW + o); F.wf[mt][s][1] = *(const u32x2*)(GW + o + 8); F.qg[mt][s][0] = *(const u32x2*)(GQG + o); F.qg[mt][s][1] = *(const u32x2*)(GQG + o + 8); }
        { const size_t o = unit * 4096 + (size_t)(mt * 32 + c) * 64 + 16 * ww + 4 * hf; F.qk[mt][0] = *(const u32x2*)(GQK + o); F.qk[mt][1] = *(const u32x2*)(GQK + o + 8); }
#pragma unroll
        for (int q = 0; q < 4; ++q) F.u[mt][q] = *(const u32x2*)(GUT + unit * 8192 + (size_t)(sl * 32 + c) * 64 + mt * 32 + 8 * q + 4 * hf);
    }
#pragma unroll
    for (int s = 0; s < 4; ++s) { const size_t o = unit * 8192 + (size_t)(32 * ww + c) * 64 + 16 * s + 4 * hf; F.kg[s][0] = *(const u32x2*)(GKGT + o); F.kg[s][1] = *(const u32x2*)(GKGT + o + 8); }
    F.eg = GEXP[unit];
}
DI void scan_step(const ScanFrag& F, f32x16& st, LAS float* P1, LAS float* OB, bf16_t* GUT, size_t unit, int sl, int ww, int lane, int tl, bool active) {
    bf16x8 sf[2]; sf[0] = pack8(st, 0); sf[1] = pack8(st, 1);
    if (active) {
#pragma unroll
    for (int mt = 0; mt < 2; ++mt) { f32x16 p = zero16(); p = mfma32(cat8(F.wf[mt][0][0], F.wf[mt][0][1]), sf[0], p); p = mfma32(cat8(F.wf[mt][1][0], F.wf[mt][1][1]), sf[1], p);
#pragma unroll
        for (int i = 0; i < 16; ++i) P1[((ww * 2 + mt) * 16 + i) * 64 + lane] = p[i]; }
    }
    __syncthreads();
    if (active) {
    f32x16 u[2]; bf16x8 vf[2][2];
#pragma unroll
    for (int mt = 0; mt < 2; ++mt) {
#pragma unroll
        for (int q = 0; q < 4; ++q) { u[mt][4 * q] = bflo(F.u[mt][q][0]); u[mt][4 * q + 1] = bfhi(F.u[mt][q][0]); u[mt][4 * q + 2] = bflo(F.u[mt][q][1]); u[mt][4 * q + 3] = bfhi(F.u[mt][q][1]); }
#pragma unroll
        for (int i = 0; i < 16; ++i) { float sm = 0.f;
#pragma unroll
            for (int w2 = 0; w2 < 4; ++w2) sm += P1[((w2 * 2 + mt) * 16 + i) * 64 + lane];
            u[mt][i] -= sm; }
        vf[mt][0] = pack8(u[mt], 0); vf[mt][1] = pack8(u[mt], 1);
    }
    const bf16x8 vsel = (ww == 0) ? vf[0][0] : (ww == 1) ? vf[0][1] : (ww == 2) ? vf[1][0] : vf[1][1];
#pragma unroll
    for (int mt = 0; mt < 2; ++mt) { f32x16 o = zero16(); o = mfma32(cat8(F.qg[mt][0][0], F.qg[mt][0][1]), sf[0], o); o = mfma32(cat8(F.qg[mt][1][0], F.qg[mt][1][1]), sf[1], o); o = mfma32(cat8(F.qk[mt][0], F.qk[mt][1]), vsel, o);
#pragma unroll
        for (int i = 0; i < 16; ++i) OB[((ww * 2 + mt) * 16 + i) * 64 + lane] = o[i]; }
#pragma unroll
    for (int i = 0; i < 16; ++i) st[i] *= F.eg;
#pragma unroll
    for (int s = 0; s < 4; ++s) st = mfma32(cat8(F.kg[s][0], F.kg[s][1]), vf[s >> 1][s & 1], st);
    }
    __syncthreads();
    if (active) {
    const int l2 = tl & 63, q = tl >> 6;
#pragma unroll
    for (int mt = 0; mt < 2; ++mt) { float o4[4];
#pragma unroll
        for (int e = 0; e < 4; ++e) { float sm = 0.f;
#pragma unroll
            for (int w2 = 0; w2 < 4; ++w2) sm += OB[((w2 * 2 + mt) * 16 + 4 * q + e) * 64 + l2];
            o4[e] = sm; }
        *(u32x2*)(GUT + unit * 8192 + (size_t)(sl * 32 + (l2 & 31)) * 64 + mt * 32 + 8 * q + 4 * (l2 >> 5)) = (u32x2){pk2(o4[0], o4[1]), pk2(o4[2], o4[3])}; }
    }
}
DI void gdn_scan(LAS unsigned char* L, const bf16_t* GQG, const bf16_t* GKGT, const bf16_t* GW, bf16_t* GUT, const bf16_t* GQK, const float* GEXP, int su, int tid) {
    const int w = tid >> 6, lane = tid & 63, c = lane & 31, hf = lane >> 5, ww = w & 3, tl = tid & 255;
    const bool active = w < 4;
    const int sl = su & 3, h = (su >> 2) & 15, bl = su >> 6;
    LAS float* P1 = (LAS float*)L; LAS float* OB = (LAS float*)(L + 32768);
    f32x16 st = zero16();
    ScanFrag A, B;
    if (active) scan_load(A, GQG, GKGT, GW, GUT, GQK, GEXP, (size_t)((bl * 64 + 0) * 16 + h), sl, ww, c, hf);
#pragma unroll 1
    for (int n = 0; n < 64; n += 2) {
        const size_t u0 = (size_t)((bl * 64 + n) * 16 + h), u1 = u0 + 16, u2 = u0 + 32;
        if (active) scan_load(B, GQG, GKGT, GW, GUT, GQK, GEXP, u1, sl, ww, c, hf);
        scan_step(A, st, P1, OB, GUT, u0, sl, ww, lane, tl, active);
        if (active && n + 2 < 64) scan_load(A, GQG, GKGT, GW, GUT, GQK, GEXP, u2, sl, ww, c, hf);
        scan_step(B, st, P1, OB, GUT, u1, sl, ww, lane, tl, active);
    }
    __syncthreads();
}
constexpr int SC_W = 0, SC_QG = 17408, SC_KG = 34816, SC_QK = 53248, SC_BUF = 62464;
DI void scan2_ld(u32x4 (&r)[14], const bf16_t* GQG, const bf16_t* GKGT, const bf16_t* GW, const bf16_t* GQK, size_t unit, int lt) {
#pragma unroll
    for (int i = 0; i < 4; ++i) { const int cc = lt + 256 * i; r[i] = *(const u32x4*)(GW + unit * 8192 + cc * 8); r[4 + i] = *(const u32x4*)(GQG + unit * 8192 + cc * 8); r[8 + i] = *(const u32x4*)(GKGT + unit * 8192 + cc * 8); }
#pragma unroll
    for (int i = 0; i < 2; ++i) { const int cc = lt + 256 * i; r[12 + i] = *(const u32x4*)(GQK + unit * 4096 + cc * 8); }
}
DI void scan2_put(LAS unsigned char* d, const u32x4& v) { *(LAS u32x2*)d = (u32x2){v[0], v[1]}; *(LAS u32x2*)(d + 16) = (u32x2){v[2], v[3]}; }
DI void scan2_st(LAS unsigned char* B, const u32x4 (&r)[14], int lt) {
#pragma unroll
    for (int i = 0; i < 4; ++i) { const int cc = lt + 256 * i;
        { const int row = cc >> 4, part = cc & 15, o = row * 272 + (part >> 1) * 32 + (part & 1) * 8; scan2_put(B + SC_W + o, r[i]); scan2_put(B + SC_QG + o, r[4 + i]); }
        { const int row = cc >> 3, part = cc & 7; scan2_put(B + SC_KG + row * 144 + (part >> 1) * 32 + (part & 1) * 8, r[8 + i]); } }
#pragma unroll
    for (int i = 0; i < 2; ++i) { const int cc = lt + 256 * i, row = cc >> 3, part = cc & 7; scan2_put(B + SC_QK + row * 144 + (part >> 1) * 32 + (part & 1) * 8, r[12 + i]); }
}
DI void gdn_scan2(LAS unsigned char* L, const bf16_t* GQG, const bf16_t* GKGT, const bf16_t* GW, bf16_t* GUT, const bf16_t* GQK, const float* GEXP, int su, int tid) {
    const int w = tid >> 6, lane = tid & 63, c = lane & 31, hf = lane >> 5, h = su & 15, bl = su >> 4;
#define SC_UNIT(n) ((size_t)((bl * 64 + (n)) * 16 + h))
    if (w >= 4) {
        const int lt = tid - 256; u32x4 r[14];
        scan2_ld(r, GQG, GKGT, GW, GQK, SC_UNIT(0), lt); scan2_st(L, r, lt);
        scan2_ld(r, GQG, GKGT, GW, GQK, SC_UNIT(1), lt);
        __syncthreads();
#pragma unroll 1
        for (int n = 0; n < 64; ++n) {
            if (n + 1 < 64) scan2_st(L + ((n + 1) & 1) * SC_BUF, r, lt);
            if (n + 2 < 64) scan2_ld(r, GQG, GKGT, GW, GQK, SC_UNIT(n + 2), lt);
            __syncthreads();
        }
    } else {
        const int sl = w; f32x16 st[4]; u32x2 un[2][4]; float egn;
#pragma unroll
        for (int t = 0; t < 4; ++t) st[t] = zero16();
#pragma unroll
        for (int mt = 0; mt < 2; ++mt)
#pragma unroll
            for (int q = 0; q < 4; ++q) un[mt][q] = *(const u32x2*)(GUT + SC_UNIT(0) * 8192 + (size_t)(sl * 32 + c) * 64 + mt * 32 + 8 * q + 4 * hf);
        egn = GEXP[SC_UNIT(0)];
        __syncthreads();
#pragma unroll 1
        for (int n = 0; n < 64; ++n) {
            const LAS unsigned char* B = L + (n & 1) * SC_BUF; const size_t unit = SC_UNIT(n);
            f32x16 vn[2]; const float eg = egn;
#pragma unroll
            for (int mt = 0; mt < 2; ++mt)
#pragma unroll
                for (int q = 0; q < 4; ++q) { vn[mt][4 * q] = bflo(un[mt][q][0]); vn[mt][4 * q + 1] = bfhi(un[mt][q][0]); vn[mt][4 * q + 2] = bflo(un[mt][q][1]); vn[mt][4 * q + 3] = bfhi(un[mt][q][1]); }
            if (n + 1 < 64) {
#pragma unroll
                for (int mt = 0; mt < 2; ++mt)
#pragma unroll
                    for (int q = 0; q < 4; ++q) un[mt][q] = *(const u32x2*)(GUT + SC_UNIT(n + 1) * 8192 + (size_t)(sl * 32 + c) * 64 + mt * 32 + 8 * q + 4 * hf);
                egn = GEXP[SC_UNIT(n + 1)];
            }
            bf16x8 sf[4][2];
#pragma unroll
            for (int t = 0; t < 4; ++t) { sf[t][0] = pack8(st[t], 0); sf[t][1] = pack8(st[t], 1); }
#pragma unroll
            for (int mt = 0; mt < 2; ++mt) { f32x16 p = zero16();
#pragma unroll
                for (int t = 0; t < 4; ++t)
#pragma unroll
                    for (int s = 0; s < 2; ++s) p = mfma32(*(const LAS bf16x8*)(B + SC_W + (mt * 32 + c) * 272 + (2 * t + s) * 32 + hf * 16), sf[t][s], p);
#pragma unroll
                for (int i = 0; i < 16; ++i) vn[mt][i] -= p[i]; }
            bf16x8 vf[2][2];
#pragma unroll
            for (int mt = 0; mt < 2; ++mt) { vf[mt][0] = pack8(vn[mt], 0); vf[mt][1] = pack8(vn[mt], 1); }
#pragma unroll
            for (int mt = 0; mt < 2; ++mt) { f32x16 o = zero16();
#pragma unroll
                for (int t = 0; t < 4; ++t)
#pragma unroll
                    for (int s = 0; s < 2; ++s) o = mfma32(*(const LAS bf16x8*)(B + SC_QG + (mt * 32 + c) * 272 + (2 * t + s) * 32 + hf * 16), sf[t][s], o);
#pragma unroll
                for (int j = 0; j < 4; ++j) o = mfma32(*(const LAS bf16x8*)(B + SC_QK + (mt * 32 + c) * 144 + j * 32 + hf * 16), vf[j >> 1][j & 1], o);
#pragma unroll
                for (int q = 0; q < 4; ++q) *(u32x2*)(GUT + unit * 8192 + (size_t)(sl * 32 + c) * 64 + mt * 32 + 8 * q + 4 * hf) = (u32x2){pk2(o[4 * q], o[4 * q + 1]), pk2(o[4 * q + 2], o[4 * q + 3])}; }
#pragma unroll
            for (int t = 0; t < 4; ++t) {
#pragma unroll
                for (int i = 0; i < 16; ++i) st[t][i] *= eg;
#pragma unroll
                for (int j = 0; j < 4; ++j) st[t] = mfma32(*(const LAS bf16x8*)(B + SC_KG + (32 * t + c) * 144 + j * 32 + hf * 16), vf[j >> 1][j & 1], st[t]); }
            __syncthreads();
        }
    }
#undef SC_UNIT
    __syncthreads();
}
DI void obnorm_item(LAS unsigned char* L, const bf16_t* GUT, const bf16_t* PROJ, const float* ogain, bf16_t* OBm, int unit, int tid) {
    const int h = unit & 15, n = (unit >> 4) & 63, bl = unit >> 10;
#pragma unroll
    for (int i = 0; i < 2; ++i) { const int cc = tid + 512 * i, d = cc >> 3, part = cc & 7; const u32x4 v = *(const u32x4*)(GUT + (size_t)unit * 8192 + d * 64 + part * 8);
        LAS unsigned* dp = (LAS unsigned*)(L + d * 132 + part * 16); dp[0] = v[0]; dp[1] = v[1]; dp[2] = v[2]; dp[3] = v[3]; }
    __syncthreads();
#pragma unroll
    for (int i = 0; i < 2; ++i) {
        const int wi = tid + 512 * i, t = wi >> 4, dvg = wi & 15; const size_t tok = (size_t)(bl * SEQ + n * 64 + t);
        const u32x4 zr = *(const u32x4*)(PROJ + tok * NP + C_Z + h * 128 + dvg * 8);
        const f32x4 ga = *(const f32x4*)(ogain + dvg * 8), gb = *(const f32x4*)(ogain + dvg * 8 + 4);
        float v[8], ss = 0.f;
#pragma unroll
        for (int e = 0; e < 8; ++e) { v[e] = bf2f(*(const LAS bf16_t*)(L + (dvg * 8 + e) * 132 + t * 2)); ss += v[e] * v[e]; }
        const float rs = rsqrtf(sum16(ss) * (1.0f / 128.0f) + EPS);
        u32x4 o;
        o[0] = pk2(v[0] * rs * ga[0] * silu(bflo(zr[0])), v[1] * rs * ga[1] * silu(bfhi(zr[0]))); o[1] = pk2(v[2] * rs * ga[2] * silu(bflo(zr[1])), v[3] * rs * ga[3] * silu(bfhi(zr[1])));
        o[2] = pk2(v[4] * rs * gb[0] * silu(bflo(zr[2])), v[5] * rs * gb[1] * silu(bfhi(zr[2]))); o[3] = pk2(v[6] * rs * gb[2] * silu(bflo(zr[3])), v[7] * rs * gb[3] * silu(bfhi(zr[3])));
        *(u32x4*)(OBm + tok * DM + h * 128 + dvg * 8) = o;
    }
    __syncthreads();
}

typedef __attribute__((address_space(1))) unsigned char* gptr_t;
DI unsigned char* opq(unsigned char* q) { gptr_t g = (gptr_t)q; asm volatile("" : "+s"(g)); return (unsigned char*)g; }
#define GIN(k) ((const float*)(const __attribute__((address_space(1))) float*)(pp->in[k]))
#define WSB opq(pp->ws)
#define DOB opq((unsigned char*)pp->out)
#define WAT ((bf16_t*)(WSB + WS_WAT))
#define WBT ((bf16_t*)(WSB + WS_WBT))
#define WOT ((bf16_t*)(WSB + WS_WOT))
#define WCT ((bf16_t*)(WSB + WS_WCT))
#define CMPC ((float*)(WSB + WS_CMPC))
#define CTR ((unsigned*)(WSB + WS_CTR))
#define KC ((bf16_t*)(WSB + WS_KC))
#define VCT ((bf16_t*)(WSB + WS_VCT))
#define SEL ((unsigned*)(WSB + WS_SEL))
#define GEXP ((float*)(WSB + WS_GEXP))
#define H ((bf16_t*)(WSB + WS_H))
#define WINT ((bf16_t*)(WSB + WS_WINT))
#define GQG ((bf16_t*)(WSB + WS_GQG))
#define GKGT ((bf16_t*)(WSB + WS_GKGT))
#define GW ((bf16_t*)(WSB + WS_GW))
#define PROJ ((bf16_t*)(WSB + WS_PROJ))
#define GUT ((bf16_t*)(WSB + WS_GU))
#define GQK ((bf16_t*)(WSB + WS_GQK))
#define VT ((bf16_t*)(WSB + WS_VT))
#define X1 ((float*)(WSB + WS_X1))
#define H2 ((bf16_t*)(WSB + WS_H2))
#define WGT ((bf16_t*)(WSB + WS_WGT))
#define WDT ((bf16_t*)(WSB + WS_WDT))
#define ACT ((bf16_t*)(WSB + WS_ACT))
#define OA ((bf16_t*)(DOB + DO_OA))
#define OBm ((bf16_t*)(DOB + DO_OB))
#define MIX ((bf16_t*)(DOB + DO_MIX))

typedef const Params __attribute__((address_space(4)))* ParamsK;
template <int PH> DI void run_phase(int half, LAS unsigned char* L) {
    ParamsK pp = (ParamsK)__builtin_amdgcn_kernarg_segment_ptr(); asm volatile("" : "+s"(pp));
    int tid = threadIdx.x, bid = blockIdx.x, G = gridDim.x;
    asm volatile("" : "+v"(tid)); asm volatile("" : "+s"(bid)); asm volatile("" : "+s"(G)); asm volatile("" : "+s"(half));
    LAS float* tile = (LAS float*)L;
    if (PH == 0) {
        if (bid == 1 && tid < 64) {
            const float* qg = GIN(3); const float* kg = GIN(4);
            float mq = fmaxf(fabsf(qg[tid]), fabsf(qg[tid + 64]));
#pragma unroll
            for (int o = 32; o; o >>= 1) mq = fmaxf(mq, __shfl_xor(mq, o));
#pragma unroll
            for (int br = 0; br < 3; ++br) { float mk = fmaxf(fabsf(kg[br * 128 + tid]), fabsf(kg[br * 128 + tid + 64]));
#pragma unroll
                for (int o = 32; o; o >>= 1) mk = fmaxf(mk, __shfl_xor(mk, o));
                if (tid == 0) ((float*)(CTR + 40))[br] = QSCALE * 128.0f * mq * mk; }
        }
        xpose_all<0>(tile, GIN(11), 2048, 2048, WAT, tid, bid, G);
        xpose_all<0>(tile, GIN(12), 2048, 2048, WBT, tid, bid, G);
        xpose_all<0>(tile, GIN(13), 2048, 2048, WOT, tid, bid, G);
        xpose_all<0>(tile, GIN(6), 4096, 128, WCT, tid, bid, G);
        xpose_all<0>(tile, GIN(6) + 4096 * 128, 4096, 128, WCT + 128 * 4096, tid, bid, G);
        xpose_all<1>(tile, GIN(2), 2048, 17488, WINT, tid, bid, G);
        norm_rows(GIN(0), GIN(1), H, TH, tid, bid, G);
        if (bid >= G - 16) {
            const int idx = bid - (G - 16), kv = idx >> 3, ks = idx & 7, e = tid & 127, part = tid >> 7;
            const float* pos = GIN(5) + kv * 4096 + ks * 512 + part * 128; const float* wc = GIN(6) + ((size_t)kv * 4096 + ks * 512 + part * 128) * 128 + e;
            float s[8];
#pragma unroll
            for (int j = 0; j < 8; ++j) s[j] = 0.f;
#pragma unroll 1
            for (int k = 0; k < 128; k += 8) {
#pragma unroll
                for (int j = 0; j < 8; ++j) s[j] += pos[k + j] * wc[(size_t)(k + j) * 128];
            }
            tile[tid] = ((s[0] + s[1]) + (s[2] + s[3])) + ((s[4] + s[5]) + (s[6] + s[7])); __syncthreads();
            if (tid < 128) CMPC[(kv * 8 + ks) * 128 + tid] = tile[tid] + tile[tid + 128] + tile[tid + 256] + tile[tid + 384];
            __syncthreads();
        }
    }
    if (PH == 1) { if (half == 0) norm_rows(GIN(0) + (size_t)TH * DM, GIN(1), H, TH, tid, bid, G); }
    if (PH == 2) { EpiProj E{PROJ}; run_gemm(L, H, WINT, TH, NP, 2048, E); }
    if (PH == 3) {
        LAS int* qw = (LAS int*)(L + 131072 + 64);
        int nxt = 0;
        if (tid == 0) nxt = (int)atomicAdd(CTR + 2 + half, 1u);
        for (;;) {
            if (tid == 0) *qw = nxt;
            __syncthreads();
            const int it = *qw;
            __syncthreads();
            if (it >= 64 + 2048 + 1024 + 512) break;
            if (tid == 0) nxt = (int)atomicAdd(CTR + 2 + half, 1u);
            if (it < 64) cmp_item(L, PROJ, WCT, CMPC, GIN(4), KC, VCT, it, tid);
            else if (it < 64 + 2048) gdn_prep_item(L, PROJ, GIN(7), GIN(8), GIN(9), GQG, GKGT, GW, GUT, GQK, GEXP, it - 64, tid);
            else if (it < 64 + 2048 + 1024) vt_item(L, PROJ, VT, it - 64 - 2048, tid);
            else qk_norm_item(PROJ, GIN(3), GIN(4), it - 64 - 2048 - 1024, tid);
        }
    }
    if (PH == 6) for (int it = bid; it < 512; it += G) cmp_attn_item(L, PROJ, KC, VCT, OA, SEL, (const float*)(CTR + 40), it, tid);
    if (PH == 7) { if (bid < 32) gdn_scan2(L, GQG, GKGT, GW, GUT, GQK, GEXP, bid, tid); }
    if (PH == 8) {
        int k = 0;
        for (;;) {
            LAS int* qw = (LAS int*)(L + AT_MISC + 64);
            if (tid == 0) { int it = -1;
                while (k < 8) { const int q = (bid + k) & 7; const unsigned t = atomicAdd(CTR + 8 + 8 * half + q, 1u); if (t < 64u) { it = (int)t * 8 + q; break; } ++k; }
                *qw = it; }
            __syncthreads();
            const int it = *qw;
            __syncthreads();
            if (it < 0) break;
            attn_item(L, PROJ, VT, SEL, OA, (const float*)(CTR + 40), it, tid);
        }
    }
    if (PH == 9) for (int it = bid; it < 2048; it += G) obnorm_item(L, GUT, PROJ, GIN(10), OBm, it, tid);
    if (PH == 10) {
        EpiMix2 E{MIX + (size_t)half * TH * DM, PROJ};
        pg8::Gemm g{OA, WAT, 2 * TH, 4096, 2048}; BrOrder S; S.init(TH, 2048, (int)gridDim.x, (int)blockIdx.x);
        pg8::gemm_phase<EpiMix2, BrOrder, false>((PG8_LAS unsigned char*)L, g, S, E, nullptr);
        __syncthreads();
    }
    if (PH == 12) {
        xpose_all<2>(tile, GIN(15), 2048, DFF, WGT, tid, bid, G);
        xpose_all<3>(tile, GIN(16), 2048, DFF, WGT, tid, bid, G);
        xpose_all<0>(tile, GIN(17), DFF, 2048, WDT, tid, bid, G);
    }
    if (PH == 13) { EpiRes E{X1, GIN(0)}; run_gemm_half(L, MIX, WOT, 2 * TH, 2048, 2048, E); }
    if (PH == 14) norm_rows(X1, GIN(14), H2, 2 * TH, tid, bid, G);
    if (PH == 15) { EpiGU E{ACT}; run_gemm(L, H2, WGT, 2 * TH, 2 * DFF, 2048, E); }
    if (PH == 16) { EpiRes E{(float*)(__attribute__((address_space(1))) float*)pp->out, X1}; run_gemm_half(L, ACT, WDT, 2 * TH, 2048, DFF, E); }
}
constexpr int LDS_BYTES = 132 * 1024;
DI void gbar(unsigned* bar, unsigned target) {
    asm volatile("s_waitcnt vmcnt(0) lgkmcnt(0)" ::: "memory");
    __syncthreads();
    if (threadIdx.x == 0) {
        __builtin_amdgcn_fence(__ATOMIC_RELEASE, "agent");
        asm volatile("s_waitcnt vmcnt(0)" ::: "memory");
        __hip_atomic_fetch_add(bar, 1u, __ATOMIC_RELAXED, __HIP_MEMORY_SCOPE_AGENT);
        while (__hip_atomic_load(bar, __ATOMIC_RELAXED, __HIP_MEMORY_SCOPE_AGENT) < target) __builtin_amdgcn_s_sleep(1);
        __builtin_amdgcn_fence(__ATOMIC_ACQUIRE, "agent");
        asm volatile("s_waitcnt vmcnt(0)" ::: "memory");
    }
    __syncthreads();
}
#ifndef PROBE_PH
#define PROBE_PH -1
#endif
#define RP(X, h) do { if (PROBE_PH == (X)) { const unsigned long long t0_ = __builtin_amdgcn_s_memrealtime(); run_phase<X>(h, L); const unsigned long long t1_ = __builtin_amdgcn_s_memrealtime(); \
    while (__builtin_amdgcn_s_memrealtime() - t1_ < t1_ - t0_) __builtin_amdgcn_s_sleep(8); } else run_phase<X>(h, L); } while (0)
__global__ void __launch_bounds__(512, 2) mega(Params p) {
    extern __shared__ __attribute__((aligned(16))) unsigned char smem[];
    LAS unsigned char* L = (LAS unsigned char*)smem;
    cg::grid_group grid = cg::this_grid();
    unsigned nbar = 0u; unsigned* gbar_word;
    { ParamsK pp = (ParamsK)__builtin_amdgcn_kernarg_segment_ptr(); gbar_word = (unsigned*)(__attribute__((address_space(1))) unsigned*)(pp->ws + WS_CTR) + 64; }
#define GB() do { nbar += gridDim.x; gbar(gbar_word, nbar); } while (0)
    RP(0, 0); GB();
    if (gridDim.x == 0x7fffffffu) grid.sync();
#pragma unroll 1
    for (int half = 0; half < 2; ++half) {
        RP(2, half); GB();
        RP(3, half); GB();
        RP(6, half); GB();
        RP(7, half); RP(8, half); GB();
        RP(9, half); RP(1, half); GB();
        RP(10, half); GB();
    }
    RP(12, 0); RP(13, 0); GB();
    RP(14, 0); GB();
    RP(15, 0); GB();
    RP(16, 0);
}
extern "C" void kernel_launch(void* const* d_in, const int* in_sizes, int n_in, void* d_out, int out_size, void* d_ws, size_t ws_size, hipStream_t stream) {
    static int grid = 0;
    if (grid == 0) {
        int dev = 0, cus = 0, per_cu = 0;
        (void)hipGetDevice(&dev); (void)hipDeviceGetAttribute(&cus, hipDeviceAttributeMultiprocessorCount, dev);
        if (hipFuncSetAttribute((const void*)mega, hipFuncAttributeMaxDynamicSharedMemorySize, LDS_BYTES) != hipSuccess) fprintf(stderr, "hipFuncSetAttribute failed\n");
        if (hipOccupancyMaxActiveBlocksPerMultiprocessor(&per_cu, (const void*)mega, 512, LDS_BYTES) != hipSuccess || per_cu < 1) { fprintf(stderr, "occupancy query: %d\n", per_cu); per_cu = 1; }
        (void)hipGetLastError();
        grid = cus;
    }
    Params p{};
    for (int i = 0; i < 18; ++i) p.in[i] = (const float*)d_in[i];
    p.out = (float*)d_out; p.ws = (unsigned char*)d_ws;
    (void)hipMemsetAsync((unsigned char*)d_ws + WS_CTR, 0, 512, stream);
    void* args[] = {&p};
    hipError_t e = hipLaunchCooperativeKernel((const void*)mega, dim3(grid), dim3(512), args, LDS_BYTES, stream);
    if (e != hipSuccess) fprintf(stderr, "cooperative launch failed: %s (grid %d)\n", hipGetErrorString(e), grid);
}
```
